# Optimizing an MI355X kernel written in HIP

```python
import math
import jax
import jax.numpy as jnp
from jax import lax
import numpy as np

D_MODEL = 1024
BATCH = 8
SEQ = 2048
DEPTH = 2
DEC_BATCH = 32
DEC_SEQ = 8
PAST_LEN = 8192
PAGE_SIZE = 128

N_A_LAYERS = DEPTH // 2
SSM_GROUP = 16
N_GROUPS = D_MODEL // SSM_GROUP
SSM_STATE = 64
DT_MIN = 1e-3
DT_MAX = 1e-1
N_HEADS = 16
HEAD_DIM = D_MODEL // N_HEADS
N_KV_HEADS = 4
GQA_GROUP = N_HEADS // N_KV_HEADS
CMP_BLOCK = 32
CMP_STRIDE = 16
CMP_HIDDEN = 2 * HEAD_DIM
SEL_BLOCK = 64
N_SEL = 16
WINDOW = 512
WIN_QBLOCK = 128
SEL_QBLOCK = 32
ROPE_THETA = 10000.0
D_FF = 2816
CONV_WIDTH = 3
EPS = 1e-6
NEG = -1e30

kernel_name = 'yoco_s5_nsa_convffn_step'


def rms_norm(x, g):
    x32 = x.astype(jnp.float32)
    y = x32 * lax.rsqrt(jnp.mean(x32 * x32, axis=-1, keepdims=True) + EPS)
    return (y * g.astype(jnp.float32)).astype(x.dtype)


def adaln(c, w, b, n):
    return jnp.split(jax.nn.silu(c) @ w + b, n, axis=-1)


def modulate(h, shift, scale):
    return h * (1.0 + scale[:, None, :]) + shift[:, None, :]


def rope(x, pos):
    half = x.shape[-1] // 2
    freqs = ROPE_THETA ** (-jnp.arange(half, dtype=jnp.float32) / half)
    ang = pos.astype(jnp.float32)[:, None] * freqs[None, :]
    cos = jnp.cos(ang)[None, :, None, :]
    sin = jnp.sin(ang)[None, :, None, :]
    x1, x2 = x[..., :half], x[..., half:]
    return jnp.concatenate([x1 * cos - x2 * sin, x2 * cos + x1 * sin], axis=-1).astype(x.dtype)


def cmul(ar, ai, br, bi):
    return ar * br - ai * bi, ar * bi + ai * br


def s5_mixer(h, lam_re, lam_im, log_dt, b_re, b_im, c_re, c_im, d_skip, w_glu, b_glu, h0):
    f32 = jnp.float32
    bsz, seq, _ = h.shape
    h32 = h.astype(f32)
    u = h32.reshape(bsz, seq, N_GROUPS, SSM_GROUP)
    dt = jnp.exp(log_dt.astype(f32))[:, None]
    lr, li = lam_re.astype(f32), lam_im.astype(f32)
    mag = jnp.exp(lr * dt)
    a_re, a_im = mag * jnp.cos(li * dt), mag * jnp.sin(li * dt)
    den = lr * lr + li * li
    z_re, z_im = cmul(a_re - 1.0, a_im, lr / den, -li / den)
    bu_re, bu_im = cmul(z_re, z_im,
                        jnp.einsum('blgc,gpc->blgp', u, b_re.astype(f32)),
                        jnp.einsum('blgc,gpc->blgp', u, b_im.astype(f32)))
    a_shape = (1, seq) + a_re.shape

    def combine(e1, e2):
        a1r, a1i, b1r, b1i = e1
        a2r, a2i, b2r, b2i = e2
        ar, ai = cmul(a2r, a2i, a1r, a1i)
        br, bi = cmul(a2r, a2i, b1r, b1i)
        return ar, ai, br + b2r, bi + b2i

    acc_re, acc_im, s_re, s_im = lax.associative_scan(
        combine, (jnp.broadcast_to(a_re, a_shape), jnp.broadcast_to(a_im, a_shape), bu_re, bu_im), axis=1)
    if h0 is not None:
        p_re, p_im = cmul(acc_re, acc_im, h0[0].astype(f32)[:, None], h0[1].astype(f32)[:, None])
        s_re, s_im = s_re + p_re, s_im + p_im
    y = (jnp.einsum('blgp,gcp->blgc', s_re, c_re.astype(f32))
         - jnp.einsum('blgp,gcp->blgc', s_im, c_im.astype(f32)))
    y = y.reshape(bsz, seq, D_MODEL) + d_skip.astype(f32) * h32
    g = jax.nn.gelu(y)
    out = g * jax.nn.sigmoid(g @ w_glu.astype(f32) + b_glu.astype(f32))
    return out.astype(h.dtype), s_re[:, -1], s_im[:, -1]


def conv_ffn(h, w_up, conv_w, conv_b, w_down, prefix):
    seq = h.shape[1]
    up = h @ w_up
    ext = jnp.concatenate([prefix.astype(up.dtype), up], axis=1)
    conv = conv_b
    for k in range(CONV_WIDTH):
        conv = conv + conv_w[k] * ext[:, k:k + seq]
    a, g = jnp.split(conv, 2, axis=-1)
    out = (jax.nn.silu(g) * a) @ w_down
    return out, ext[:, -(CONV_WIDTH - 1):]


def shared_kv(x, c, pos, p):
    bsz, seq, _ = x.shape
    shift, scale = adaln(c, p['w_mod_kv'], p['b_mod_kv'], 2)
    h = modulate(rms_norm(x, p['norm_kv']), shift, scale)
    kv = (h @ p['w_kv']).reshape(bsz, seq, 6, N_KV_HEADS, HEAD_DIM)
    rows = jnp.stack([kv[:, :, 0], kv[:, :, 1], rope(kv[:, :, 2], pos), kv[:, :, 3]], axis=2)
    win_rows = jnp.stack([rope(kv[:, :, 4], pos), kv[:, :, 5]], axis=2)
    return rows, win_rows


def compress(rows, pe, w1, b1, w2):
    t = rows.shape[1]
    nc = (t - CMP_BLOCK) // CMP_STRIDE + 1
    idx = np.arange(nc)[:, None] * CMP_STRIDE + np.arange(CMP_BLOCK)[None, :]
    blocks = rows[:, idx] + pe[None, None, :, None, :]
    hid = jax.nn.gelu(jnp.einsum('bnlkd,ldh->bnkh', blocks, w1.reshape(CMP_BLOCK, HEAD_DIM, CMP_HIDDEN)) + b1)
    return jnp.einsum('bnkh,hd->bnkd', hid, w2)


def sel_blocks(k):
    bsz, t = k.shape[:2]
    ns = -(-t // SEL_BLOCK)
    k = jnp.pad(k, ((0, 0), (0, ns * SEL_BLOCK - t), (0, 0), (0, 0)))
    return k.reshape(bsz, ns, SEL_BLOCK, N_KV_HEADS, HEAD_DIM).transpose(0, 3, 1, 2, 4)


def window_band(win_rows):
    seq = win_rows.shape[1]
    nqb = seq // WIN_QBLOCK
    pad = jnp.pad(win_rows, ((0, 0), (WINDOW, 0), (0, 0), (0, 0), (0, 0)))
    idx = np.arange(nqb)[:, None] * WIN_QBLOCK + np.arange(WINDOW + WIN_QBLOCK)[None, :]
    band = pad[:, idx]
    return band[:, :, :, 0], band[:, :, :, 1], jnp.asarray(idx - WINDOW)


def cmp_to_sel_matrix(nc, ns):
    r = SEL_BLOCK // CMP_STRIDE
    q = CMP_BLOCK // CMP_STRIDE
    offs = (np.arange(r)[:, None] - np.arange(q)[None, :]).reshape(-1)
    target = r * np.arange(ns)[None, :, None] + offs[None, None, :]
    m = (np.arange(nc)[:, None, None] == target).sum(-1)
    return jnp.asarray(m, jnp.float32)


def compressed_attention(qg, kc, vc, q_pos):
    nc = kc.shape[1]
    s = jnp.einsum('bqkgd,bckd->bkgqc', qg, kc).astype(jnp.float32)
    ends = jnp.arange(nc) * CMP_STRIDE + CMP_BLOCK - 1
    valid = ends[None, :] <= q_pos[:, None]
    p = jax.nn.softmax(jnp.where(valid, s, NEG), axis=-1) * valid
    o = jnp.einsum('bkgqc,bckd->bqkgd', p.astype(vc.dtype), vc)
    return o, p


def select_blocks(p_cmp, q_pos, ns):
    nc = p_cmp.shape[-1]
    score = jnp.einsum('bkgqc,cs->bkqs', p_cmp, cmp_to_sel_matrix(nc, ns))
    j = jnp.arange(ns)[None, :]
    cur = q_pos[:, None] // SEL_BLOCK
    valid = j * SEL_BLOCK <= q_pos[:, None]
    forced = (j == 0) | (j == cur) | (j == cur - 1)
    score = jnp.where(forced, jnp.inf, jnp.where(valid, score, -jnp.inf))
    return lax.top_k(score, min(N_SEL, ns))[1]


def selected_attention(qg, kb, vb, idx, q_pos):
    bsz, nkv = kb.shape[:2]
    bi = jnp.arange(bsz)[:, None, None, None]
    hi = jnp.arange(nkv)[None, :, None, None]
    kg = kb[bi, hi, idx]
    vg = vb[bi, hi, idx]
    s = jnp.einsum('bqkgd,bkqsld->bkgqsl', qg, kg).astype(jnp.float32)
    kpos = idx[..., None] * SEL_BLOCK + jnp.arange(SEL_BLOCK)
    mask = (kpos <= q_pos[None, None, :, None, None])[:, :, None]
    sh = s.shape
    p = jax.nn.softmax(jnp.where(mask, s, NEG).reshape(sh[:4] + (-1,)), axis=-1).reshape(sh)
    return jnp.einsum('bkgqsl,bkqsld->bqkgd', p.astype(vg.dtype), vg)


def selected_attention_blocked(qg, kb, vb, idx, q_pos, qblock):
    bsz, nq = qg.shape[:2]
    nb = nq // qblock
    qs = jnp.moveaxis(qg.reshape((bsz, nb, qblock) + qg.shape[2:]), 1, 0)
    ids = jnp.moveaxis(idx.reshape(idx.shape[:2] + (nb, qblock, idx.shape[-1])), 2, 0)
    ps = q_pos.reshape(nb, qblock)
    out = lax.map(lambda a: selected_attention(a[0], kb, vb, a[1], a[2]), (qs, ids, ps))
    return jnp.moveaxis(out, 0, 1).reshape((bsz, nq) + out.shape[3:])


def window_attention(qg, kb, vb, q_pos, k_pos):
    bsz, nq = qg.shape[:2]
    n = kb.shape[1]
    qb = qg.reshape((bsz, n, nq // n) + qg.shape[2:])
    qp = q_pos.reshape(n, nq // n)
    s = jnp.einsum('bnqkgd,bnskd->bnkgqs', qb, kb).astype(jnp.float32)
    diff = qp[:, :, None] - k_pos[:, None, :]
    mask = (diff >= 0) & (diff < WINDOW) & (k_pos[:, None, :] >= 0)
    p = jax.nn.softmax(jnp.where(mask[None, :, None, None], s, NEG), axis=-1)
    o = jnp.einsum('bnkgqs,bnskd->bnqkgd', p.astype(vb.dtype), vb)
    return o.reshape((bsz, nq) + o.shape[3:])


def nsa_mixer(h, pos, w_qg, w_o, ctx):
    bsz, nq, _ = h.shape
    proj = h @ w_qg
    q = proj[..., :N_HEADS * HEAD_DIM].reshape(bsz, nq, N_HEADS, HEAD_DIM)
    gates = jax.nn.sigmoid(proj[..., N_HEADS * HEAD_DIM:].astype(jnp.float32)).reshape(bsz, nq, 3, N_HEADS, 1)
    scale = HEAD_DIM ** -0.5
    grp = (bsz, nq, N_KV_HEADS, GQA_GROUP, HEAD_DIM)
    q_plain = (q * scale).reshape(grp)
    q_rot = (rope(q, pos) * scale).reshape(grp)
    o_cmp, p_cmp = compressed_attention(q_plain, ctx['kc'], ctx['vc'], pos)
    idx = select_blocks(p_cmp, pos, ctx['ks'].shape[2])
    qblk = SEL_QBLOCK if nq % SEL_QBLOCK == 0 else nq
    o_sel = selected_attention_blocked(q_rot, ctx['ks'], ctx['vs'], idx, pos, qblk)
    o_win = window_attention(q_rot, ctx['wk'], ctx['wv'], pos, ctx['wpos'])
    hs = (bsz, nq, N_HEADS, HEAD_DIM)
    o = (gates[:, :, 0] * o_cmp.reshape(hs) + gates[:, :, 1] * o_sel.reshape(hs)
         + gates[:, :, 2] * o_win.reshape(hs))
    return o.reshape(bsz, nq, N_HEADS * HEAD_DIM).astype(h.dtype) @ w_o


def build_context(rows, win_rows, past, p):
    seq = rows.shape[1]
    if past is None:
        full = rows
        wk, wv, wpos = window_band(win_rows)
        win_state = win_rows[:, -min(WINDOW, seq):]
    else:
        pool, table = past['pool'], past['page_table']
        past_rows = pool[table].reshape((table.shape[0], table.shape[1] * pool.shape[1]) + pool.shape[2:])
        past_len = past_rows.shape[1]
        full = jnp.concatenate([past_rows.astype(rows.dtype), rows], axis=1)
        w_buf = past['win'].shape[1]
        win_all = jnp.concatenate([past['win'].astype(win_rows.dtype), win_rows], axis=1)[:, None]
        wk, wv = win_all[:, :, :, 0], win_all[:, :, :, 1]
        wpos = (past_len - w_buf + jnp.arange(w_buf + seq))[None, :]
        win_state = win_rows
    kc = compress(full[:, :, 0], p['cmp_pe'][0], p['cmp_w1'][0], p['cmp_b1'][0], p['cmp_w2'][0])
    vc = compress(full[:, :, 1], p['cmp_pe'][1], p['cmp_w1'][1], p['cmp_b1'][1], p['cmp_w2'][1])
    ctx = {'kc': kc, 'vc': vc, 'ks': sel_blocks(full[:, :, 2]), 'vs': sel_blocks(full[:, :, 3]),
           'wk': wk, 'wv': wv, 'wpos': wpos}
    return ctx, win_state


def group_forward(x, c, pos, p, past):
    bsz = x.shape[0]
    ssm_re, ssm_im, convs = [], [], []
    ctx = None
    for layer in range(DEPTH):
        shift, scale, gate = adaln(c, p['w_mod'][layer, 0], p['b_mod'][layer, 0], 3)
        h = modulate(rms_norm(x, p['norm_pre'][layer, 0]), shift, scale)
        if layer < N_A_LAYERS:
            h0 = None if past is None else (past['ssm_re'][layer], past['ssm_im'][layer])
            out, s_re, s_im = s5_mixer(h, p['ssm_lam_re'][layer], p['ssm_lam_im'][layer], p['ssm_log_dt'][layer],
                                       p['ssm_b_re'][layer], p['ssm_b_im'][layer], p['ssm_c_re'][layer],
                                       p['ssm_c_im'][layer], p['ssm_d'][layer], p['w_glu'][layer],
                                       p['b_glu'][layer], h0)
            ssm_re.append(s_re)
            ssm_im.append(s_im)
        else:
            j = layer - N_A_LAYERS
            out = nsa_mixer(h, pos, p['w_qg'][j], p['w_o'][j], ctx)
        x = x + gate[:, None, :] * rms_norm(out, p['norm_post'][layer, 0])
        shift, scale, gate = adaln(c, p['w_mod'][layer, 1], p['b_mod'][layer, 1], 3)
        h = modulate(rms_norm(x, p['norm_pre'][layer, 1]), shift, scale)
        if past is None:
            prefix = jnp.zeros((bsz, CONV_WIDTH - 1, 2 * D_FF), h.dtype)
        else:
            prefix = past['conv'][layer]
        out, conv_state = conv_ffn(h, p['ffn_w_up'][layer], p['ffn_conv_w'][layer], p['ffn_conv_b'][layer],
                                   p['ffn_w_down'][layer], prefix)
        convs.append(conv_state)
        x = x + gate[:, None, :] * rms_norm(out, p['norm_post'][layer, 1])
        if layer == N_A_LAYERS - 1:
            rows, win_rows = shared_kv(x, c, pos, p)
            ctx, win_state = build_context(rows, win_rows, past, p)
    return x, rows, win_state, jnp.stack(ssm_re), jnp.stack(ssm_im), jnp.stack(convs)


def setup_inputs(seed: int = 0) -> dict:
    key = jax.random.key(seed)
    ks = iter(jax.random.split(key, 64))

    def nrm(shape, scale=1.0):
        return jax.random.normal(next(ks), shape, jnp.float32) * scale

    n_a, n_b = N_A_LAYERS, DEPTH - N_A_LAYERS
    n_pages = PAST_LEN // PAGE_SIZE
    n_used = DEC_BATCH * n_pages
    n_phys = n_used + max(1, n_used // 4)
    kvd = (N_KV_HEADS, HEAD_DIM)
    d2f = 2 * D_FF
    page_table = jax.random.permutation(next(ks), n_phys)[:n_used].reshape(DEC_BATCH, n_pages).astype(jnp.int32)
    lam_im = jnp.pi * jnp.arange(SSM_STATE, dtype=jnp.float32) + nrm((n_a, N_GROUPS, SSM_STATE), 0.01)
    log_dt = jax.random.uniform(next(ks), (n_a, N_GROUPS), jnp.float32, math.log(DT_MIN), math.log(DT_MAX))
    return {
        'x_prompt': nrm((BATCH, SEQ, D_MODEL)),
        'x_sample': nrm((DEC_BATCH, DEC_SEQ, D_MODEL)),
        'cache_nsa_paged': nrm((n_phys, PAGE_SIZE, 4) + kvd),
        'cache_nsa_window': nrm((DEC_BATCH, min(WINDOW, PAST_LEN), 2) + kvd),
        'state_ssm_re': nrm((n_a, DEC_BATCH, N_GROUPS, SSM_STATE), 0.1),
        'state_ssm_im': nrm((n_a, DEC_BATCH, N_GROUPS, SSM_STATE), 0.1),
        'state_ffn_conv': nrm((DEPTH, DEC_BATCH, CONV_WIDTH - 1, d2f)),
        'page_table': page_table,
        'c_prompt': nrm((BATCH, D_MODEL)),
        'c_sample': nrm((DEC_BATCH, D_MODEL)),
        'norm_pre': 1.0 + nrm((DEPTH, 2, D_MODEL), 0.01),
        'norm_post': 1.0 + nrm((DEPTH, 2, D_MODEL), 0.01),
        'w_mod': nrm((DEPTH, 2, D_MODEL, 3 * D_MODEL), 0.5 * D_MODEL ** -0.5),
        'b_mod': nrm((DEPTH, 2, 3 * D_MODEL), 0.2),
        'ssm_lam_re': -0.5 + nrm((n_a, N_GROUPS, SSM_STATE), 0.01),
        'ssm_lam_im': lam_im,
        'ssm_log_dt': log_dt,
        'ssm_b_re': nrm((n_a, N_GROUPS, SSM_STATE, SSM_GROUP), (2 * SSM_GROUP) ** -0.5),
        'ssm_b_im': nrm((n_a, N_GROUPS, SSM_STATE, SSM_GROUP), (2 * SSM_GROUP) ** -0.5),
        'ssm_c_re': nrm((n_a, N_GROUPS, SSM_GROUP, SSM_STATE), (2 * SSM_STATE) ** -0.5),
        'ssm_c_im': nrm((n_a, N_GROUPS, SSM_GROUP, SSM_STATE), (2 * SSM_STATE) ** -0.5),
        'ssm_d': nrm((n_a, D_MODEL), 0.5),
        'w_glu': nrm((n_a, D_MODEL, D_MODEL), D_MODEL ** -0.5),
        'b_glu': nrm((n_a, D_MODEL), 0.02),
        'ffn_w_up': nrm((DEPTH, D_MODEL, d2f), D_MODEL ** -0.5),
        'ffn_conv_w': nrm((DEPTH, CONV_WIDTH, d2f), CONV_WIDTH ** -0.5),
        'ffn_conv_b': nrm((DEPTH, d2f), 0.02),
        'ffn_w_down': nrm((DEPTH, D_FF, D_MODEL), D_FF ** -0.5),
        'norm_kv': 1.0 + nrm((D_MODEL,), 0.01),
        'w_mod_kv': nrm((D_MODEL, 2 * D_MODEL), 0.5 * D_MODEL ** -0.5),
        'b_mod_kv': nrm((2 * D_MODEL,), 0.2),
        'w_kv': nrm((D_MODEL, 6 * N_KV_HEADS * HEAD_DIM), D_MODEL ** -0.5),
        'cmp_pe': nrm((2, CMP_BLOCK, HEAD_DIM), 0.5),
        'cmp_w1': nrm((2, CMP_BLOCK * HEAD_DIM, CMP_HIDDEN), (CMP_BLOCK * HEAD_DIM) ** -0.5),
        'cmp_b1': nrm((2, CMP_HIDDEN), 0.02),
        'cmp_w2': nrm((2, CMP_HIDDEN, HEAD_DIM), CMP_HIDDEN ** -0.5),
        'w_qg': nrm((n_b, D_MODEL, N_HEADS * HEAD_DIM + 3 * N_HEADS), D_MODEL ** -0.5),
        'w_o': nrm((n_b, N_HEADS * HEAD_DIM, D_MODEL), (N_HEADS * HEAD_DIM) ** -0.5),
    }


def reference(x_prompt, x_sample, cache_nsa_paged, cache_nsa_window, state_ssm_re, state_ssm_im,
              state_ffn_conv, page_table, c_prompt, c_sample, norm_pre, norm_post, w_mod, b_mod,
              ssm_lam_re, ssm_lam_im, ssm_log_dt, ssm_b_re, ssm_b_im, ssm_c_re, ssm_c_im, ssm_d,
              w_glu, b_glu, ffn_w_up, ffn_conv_w, ffn_conv_b, ffn_w_down, norm_kv, w_mod_kv, b_mod_kv,
              w_kv, cmp_pe, cmp_w1, cmp_b1, cmp_w2, w_qg, w_o):
    p = {'norm_pre': norm_pre, 'norm_post': norm_post, 'w_mod': w_mod, 'b_mod': b_mod,
         'ssm_lam_re': ssm_lam_re, 'ssm_lam_im': ssm_lam_im, 'ssm_log_dt': ssm_log_dt,
         'ssm_b_re': ssm_b_re, 'ssm_b_im': ssm_b_im, 'ssm_c_re': ssm_c_re, 'ssm_c_im': ssm_c_im,
         'ssm_d': ssm_d, 'w_glu': w_glu, 'b_glu': b_glu, 'ffn_w_up': ffn_w_up, 'ffn_conv_w': ffn_conv_w,
         'ffn_conv_b': ffn_conv_b, 'ffn_w_down': ffn_w_down, 'norm_kv': norm_kv, 'w_mod_kv': w_mod_kv,
         'b_mod_kv': b_mod_kv, 'w_kv': w_kv, 'cmp_pe': cmp_pe, 'cmp_w1': cmp_w1, 'cmp_b1': cmp_b1,
         'cmp_w2': cmp_w2, 'w_qg': w_qg, 'w_o': w_o}
    past = {'pool': cache_nsa_paged, 'page_table': page_table, 'win': cache_nsa_window,
            'ssm_re': state_ssm_re, 'ssm_im': state_ssm_im, 'conv': state_ffn_conv}
    past_len = page_table.shape[1] * cache_nsa_paged.shape[1]
    pos_p = jnp.arange(x_prompt.shape[1])
    pos_s = past_len + jnp.arange(x_sample.shape[1])
    y_p, rows_p, win_p, sre_p, sim_p, conv_p = group_forward(x_prompt, c_prompt, pos_p, p, None)
    y_s, rows_s, win_s, sre_s, sim_s, conv_s = group_forward(x_sample, c_sample, pos_s, p, past)
    return (y_p, y_s, rows_p, rows_s, win_p, win_s, sre_p, sim_p, sre_s, sim_s, conv_p, conv_s)
```

```cpp
#include <hip/hip_runtime.h>
#include <stdint.h>
#include <stdio.h>
#include <math.h>

namespace cfg {
constexpr int D = 1024, BP = 8, LP = 2048, BS = 32, LS = 8, RP = BP * LP, RS = BS * LS, R = RP + RS, NSEQ = BP + BS;
constexpr int PAST = 8192, PAGE = 128, NPAGES = 64;
constexpr int G = 64, P = 64;
constexpr int NH = 16, HD = 64, KVH = 4;
constexpr int FF = 2816, F2 = 5632;
constexpr int NQG = 1072, NKV = 1536;
constexpr int WIN = 512;
constexpr int NC_P = 127, NC_S = 511, NS_P = 32, NS_S = 129, NSEL = 16;
constexpr int MODW = 4 * 3072 + 2048;
constexpr int NROPE = LP + LS;
constexpr float EPS = 1e-6f, NEG = -1e30f;
constexpr size_t O_Y = 0, O_ROWS = (size_t)R * 1024, O_WIN_P = O_ROWS + (size_t)R * 1024, O_WIN_S = O_WIN_P + (size_t)BP * WIN * 512,
                 O_SRE_P = O_WIN_S + (size_t)RS * 512, O_SIM_P = O_SRE_P + BP * G * P, O_SRE_S = O_SIM_P + BP * G * P, O_SIM_S = O_SRE_S + BS * G * P,
                 O_CONV_P = O_SIM_S + BS * G * P, O_CONV_S = O_CONV_P + (size_t)2 * BP * 2 * F2, O_END = O_CONV_S + (size_t)2 * BS * 2 * F2;
static_assert(O_END == 37535744, "output size");
__host__ __device__ __forceinline__ int modrow(int row) { return row < RP ? (row >> 11) : BP + ((row - RP) >> 3); }
__host__ __device__ __forceinline__ int ropeidx(int row) { return row < RP ? (row & (LP - 1)) : LP + ((row - RP) & 7); }
}
namespace mk {
using namespace cfg;
#define LAS __attribute__((address_space(3)))
#define GAS __attribute__((address_space(1)))
typedef _Float16 h16;
typedef _Float16 h2v __attribute__((ext_vector_type(2)));
typedef _Float16 h4v __attribute__((ext_vector_type(4)));
typedef _Float16 h8v __attribute__((ext_vector_type(8)));
typedef float f32x2 __attribute__((ext_vector_type(2)));
typedef float f32x4 __attribute__((ext_vector_type(4)));
typedef float f32x16 __attribute__((ext_vector_type(16)));
typedef unsigned u32x2 __attribute__((ext_vector_type(2)));
typedef unsigned u32x4 __attribute__((ext_vector_type(4)));
typedef short s16x4 __attribute__((ext_vector_type(4)));
constexpr int NT = 512, NW = 8;
constexpr int LDS_BYTES = 147456;
constexpr int LDS_MISC = LDS_BYTES - 256;

__device__ __forceinline__ int lane_id() { int l; asm volatile("v_mbcnt_lo_u32_b32 %0, -1, 0\n\tv_mbcnt_hi_u32_b32 %0, -1, %0" : "=v"(l)); return l; }
__device__ __forceinline__ float wsum(float v) {
#pragma unroll
    for (int o = 32; o >= 1; o >>= 1) v += __shfl_xor(v, o);
    return v;
}
__device__ __forceinline__ float wmaxf(float v) {
#pragma unroll
    for (int o = 32; o >= 1; o >>= 1) v = fmaxf(v, __shfl_xor(v, o));
    return v;
}
__device__ __forceinline__ float fexp(float x) { return __builtin_amdgcn_exp2f(x * 1.4426950408889634f); }
__device__ __forceinline__ float sigm(float x) { return __builtin_amdgcn_rcpf(1.f + fexp(-x)); }
__device__ __forceinline__ float silu(float x) { return x * sigm(x); }
__device__ __forceinline__ float gelu_t(float x) { const float u = 0.7978845608028654f * (x + 0.044715f * x * x * x); return x * sigm(2.f * u); }
__device__ __forceinline__ unsigned pkh(float a, float b) { h2v v; v.x = (h16)a; v.y = (h16)b; return __builtin_bit_cast(unsigned, v); }
__device__ __forceinline__ u32x2 pkh4(f32x4 v) { u32x2 r; r.x = pkh(v[0], v[1]); r.y = pkh(v[2], v[3]); return r; }

#define XB_TMO      128
#define XB_XCNT(j)  (256  + 64 * (j))
#define XB_XSUB(j)  (1280 + 64 * (j))
#define XB_XGEN(j)  (2304 + 64 * (j))
#define XB_TOP      3328
#define XB_TOPGEN   3392
#define XCD_BAR_WORDS 3456
#define XB_SPIN_CAP (1u << 18)
__device__ __forceinline__ unsigned xb_ld(unsigned* p)              { return __hip_atomic_load(p, __ATOMIC_RELAXED, __HIP_MEMORY_SCOPE_AGENT); }
__device__ __forceinline__ unsigned xb_add(unsigned* p, unsigned v) { return __hip_atomic_fetch_add(p, v, __ATOMIC_RELAXED, __HIP_MEMORY_SCOPE_AGENT); }
__device__ __forceinline__ unsigned xb_xcc_id() { return (unsigned)__builtin_amdgcn_s_getreg((3 << 11) | 20) & 0xFu; }
#define XB_SPIN(cond, bar) do { unsigned _sp = 0; while (cond) { __builtin_amdgcn_s_sleep(1); \
    if ((++_sp & 255u) == 0u) { if (xb_ld(&(bar)[XB_TMO])) break; if (_sp > XB_SPIN_CAP) { atomicAdd(&(bar)[XB_TMO], 1u); break; } } } } while (0)
struct XcdBarrier { unsigned* bar; unsigned x; volatile LAS unsigned* st; };
__device__ __forceinline__ XcdBarrier xcd_barrier_post(unsigned* bar, volatile LAS unsigned* st, int wave) {
    XcdBarrier b; b.bar = bar; b.x = xb_xcc_id(); b.st = st;
    if (wave == 0 && lane_id() == 0) (void)xb_add(&bar[XB_XCNT(b.x)], 1u);
    return b;
}
__device__ __forceinline__ void xcd_barrier_complete(unsigned* bar, unsigned x, unsigned& nloc, unsigned& nx) {
    const unsigned G = gridDim.x * gridDim.y * gridDim.z;
    unsigned sum, cnt, mine, sp = 0u;
    for (;;) {
        sum = 0u; cnt = 0u; mine = 0u;
#pragma unroll
        for (unsigned j = 0; j < 16; ++j) { const unsigned c = xb_ld(&bar[XB_XCNT(j)]); sum += c; cnt += (c > 0u) ? 1u : 0u; mine = (j == x) ? c : mine; }
        if (sum == G) break;
        __builtin_amdgcn_s_sleep(1);
        if ((++sp & 255u) == 0u) { if (xb_ld(&bar[XB_TMO])) break; if (sp > XB_SPIN_CAP) { atomicAdd(&bar[XB_TMO], 1u); break; } }
    }
    nloc = mine > 0u ? mine : 1u; nx = cnt > 0u ? cnt : 1u;
}
__device__ __forceinline__ void xcd_barrier(const XcdBarrier& b, int wave) {
    asm volatile("s_waitcnt vmcnt(0)" ::: "memory");
    __syncthreads();
    if (wave == 0 && lane_id() == 0) {
        unsigned* bar = b.bar;
        __builtin_amdgcn_s_waitcnt(0);
        unsigned nloc = b.st[0], nx = b.st[1];
        if (nloc == 0u) { xcd_barrier_complete(bar, b.x, nloc, nx); b.st[0] = nloc; b.st[1] = nx; }
        const unsigned old = xb_add(&bar[XB_XSUB(b.x)], 1u);
        const unsigned gen = old / nloc;
        if (old + 1u == (gen + 1u) * nloc) {
            __builtin_amdgcn_fence(__ATOMIC_RELEASE, "agent");
            asm volatile("s_waitcnt vmcnt(0)" ::: "memory");
            const unsigned og = xb_add(&bar[XB_TOP], 1u);
            const unsigned tg = og / nx;
            if (og + 1u == (tg + 1u) * nx) xb_add(&bar[XB_TOPGEN], 1u);
            else XB_SPIN(xb_ld(&bar[XB_TOPGEN]) == tg, bar);
            __builtin_amdgcn_fence(__ATOMIC_ACQUIRE, "agent");
            xb_add(&bar[XB_XGEN(b.x)], 1u);
            asm volatile("s_waitcnt vmcnt(0)" ::: "memory");
        } else {
            XB_SPIN(xb_ld(&bar[XB_XGEN(b.x)]) == gen, bar);
            __builtin_amdgcn_fence(__ATOMIC_ACQUIRE, "agent");
            asm volatile("s_waitcnt vmcnt(0)" ::: "memory");
        }
    }
    __syncthreads();
}

namespace pg8 {
constexpr int BM = 256, BK = 64, HALF = 128, HTB = HALF * BK * 2, STAGE_BYTES = 8 * HTB, NXCD = 8, WGM = 8;
__host__ __device__ __forceinline__ int lds_byte(int r, int c) { const int st = (r >> 4) * 2 + (c >> 5), rr = r & 15, cc = c & 31, ob = rr * 64 + cc * 2; return st * 1024 + (ob ^ (((ob >> 9) & 1) << 5)); }
__host__ __device__ __forceinline__ void stage_rc(int b, int& R_, int& C_) { const int st = b / 1024, sb = b % 1024, swz = sb ^ (((sb >> 9) & 1) << 5); R_ = (st >> 1) * 16 + swz / 64; C_ = (st & 1) * 32 + (swz % 64) / 2; }
__host__ __device__ __forceinline__ int perm32(int rho) { const int n = rho >> 4, i = rho & 15; return 8 * (i >> 2) + 4 * n + (i & 3); }
struct Unit { int pm, pn, sub; };
struct StaticOrder {
    int nM, nN, nwg, G, c;
    __device__ void init(int M, int N, int G_, int c_) { nM = M / BM; nN = N / BM; nwg = nM * nN; G = G_; c = c_; }
    __device__ bool next(int i, Unit& u) const {
        const long L = (long)i * G + c; if (L >= nwg) return false;
        int wgid = (int)L; { const int q = nwg / NXCD, r = nwg % NXCD, xcd = wgid % NXCD, off = wgid / NXCD; wgid = (xcd < r ? xcd * (q + 1) : r * (q + 1) + (xcd - r) * q) + off; }
        const int nig = WGM * nN, gid = wgid / nig, fm = gid * WGM, gsz = (nM - fm) < WGM ? (nM - fm) : WGM;
        u.pm = fm + ((wgid % nig) % gsz); u.pn = (wgid % nig) / gsz; u.sub = 0; return true;
    }
};
struct PlainLay {
    const h16* A; const h16* Bt; int K;
    __device__ __forceinline__ unsigned a_rowoff(int r) const { return (unsigned)r * (unsigned)K * 2u; }
    __device__ __forceinline__ unsigned b_rowoff(int r) const { return (unsigned)r * (unsigned)K * 2u; }
    __device__ __forceinline__ size_t a_kstep() const { return 128; }
    __device__ __forceinline__ const char* a_ptr(const Unit& u) const { return (const char*)A + (size_t)u.pm * 256 * K * 2; }
    __device__ __forceinline__ const char* b_ptr(const Unit& u) const { return (const char*)Bt + (size_t)u.pn * 256 * K * 2; }
};
struct SplitOrder { int G, c, n; __device__ bool next(int i, Unit& u) const { const int L = i * G + c; if (L >= n) return false; u.pm = 0; u.pn = L & 3; u.sub = L >> 2; return true; } };
struct SplitLay {
    const h16* A; const h16* Bt; int K;
    __device__ __forceinline__ unsigned a_rowoff(int r) const { return (unsigned)r * (unsigned)K * 2u; }
    __device__ __forceinline__ unsigned b_rowoff(int r) const { return (unsigned)r * (unsigned)K * 2u; }
    __device__ __forceinline__ size_t a_kstep() const { return 128; }
    __device__ __forceinline__ const char* a_ptr(const Unit& u) const { return (const char*)A + (size_t)u.sub * 512; }
    __device__ __forceinline__ const char* b_ptr(const Unit& u) const { return (const char*)Bt + (size_t)u.pn * 256 * K * 2 + (size_t)u.sub * 512; }
};

template <class Epi, class Sched, class Lay>
__device__ __forceinline__ void gemm_phase(LAS unsigned char* lds, const int wave, const int K, const Sched& S, const Lay& L, const Epi& E) {
    int tid = wave * 64 + lane_id(); asm volatile("" : "+v"(tid));
    const int wid = wave, lane = tid & 63, wr = wid >> 2, wc = wid & 3, fr = lane & 15, fq = lane >> 4;
    const int nt = K / BK;
    unsigned voffA[2], voffB[2];
#pragma unroll
    for (int i = 0; i < 2; ++i) { int R_, C_; stage_rc(tid * 16 + i * 8192, R_, C_); const int Rb = Epi::PERM ? ((R_ & ~31) + perm32(R_ & 31)) : R_;
        voffA[i] = L.a_rowoff(R_) + (unsigned)C_ * 2u; voffB[i] = L.b_rowoff(Rb) + (unsigned)C_ * 2u; }
    const size_t kstepA = L.a_kstep(), kstepB = (size_t)(BK * 2);
    const size_t hstepA = (size_t)L.a_rowoff(HALF), hstepB = (size_t)L.b_rowoff(HALF);
    const unsigned ldsw = (unsigned)wid * 1024u;
    const int aoff = lds_byte(wr * 64 + fr, fq * 8), boff = lds_byte(wc * 32 + fr, fq * 8);
#define PG8_SA(b, h) (((b) * 2 + (h)) * HTB)
#define PG8_SB(b, h) ((4 + (b) * 2 + (h)) * HTB)
#define PG8_STAGE(bufoff, gbase, voff) do { _Pragma("unroll") for (int _i = 0; _i < 2; ++_i) \
        __builtin_amdgcn_global_load_lds((const unsigned*)((const char*)(gbase) + (voff)[_i]), (LAS unsigned*)(lds + (bufoff) + ldsw + _i * 8192), 16, 0, 0); } while (0)
#define PG8_LDA(dst, b, h) do { _Pragma("unroll") for (int m = 0; m < 4; ++m) _Pragma("unroll") for (int k = 0; k < 2; ++k) dst[m][k] = *(const LAS h8v*)(lds + PG8_SA(b, h) + aoff + m * 2048 + k * 1024); } while (0)
#define PG8_LDB(dst, b, h) do { _Pragma("unroll") for (int n = 0; n < 2; ++n) _Pragma("unroll") for (int k = 0; k < 2; ++k) dst[n][k] = *(const LAS h8v*)(lds + PG8_SB(b, h) + boff + n * 2048 + k * 1024); } while (0)
#define PG8_MMA(ai, bj, At, Bt) do { __builtin_amdgcn_s_setprio(1); _Pragma("unroll") for (int m = 0; m < 4; ++m) _Pragma("unroll") for (int n = 0; n < 2; ++n) _Pragma("unroll") for (int k = 0; k < 2; ++k) \
        acc[ai][bj][m][n] = __builtin_amdgcn_mfma_f32_16x16x32_f16(Bt[n][k], At[m][k], acc[ai][bj][m][n], 0, 0, 0); __builtin_amdgcn_s_setprio(0); } while (0)
#define PG8_WAIT_V(n) asm volatile("s_waitcnt vmcnt(" #n ")" ::: "memory")
#define PG8_WAIT_L(n) asm volatile("s_waitcnt lgkmcnt(" #n ")" ::: "memory")
#define PG8_BAR __builtin_amdgcn_s_barrier()
#define PG8_SCHED __builtin_amdgcn_sched_barrier(0)
    Unit cur, nxt; int ui = 0;
    if (!S.next(0, cur)) return;
    f32x4 acc[2][2][4][2];
#pragma unroll
    for (int a = 0; a < 2; ++a)
#pragma unroll
        for (int b = 0; b < 2; ++b)
#pragma unroll
            for (int m = 0; m < 4; ++m)
#pragma unroll
                for (int n = 0; n < 2; ++n) acc[a][b][m][n] = (f32x4){0.f, 0.f, 0.f, 0.f};
    h8v At[4][2], B0[2][2], B1[2][2];
    const char* cA = L.a_ptr(cur); const char* cB = L.b_ptr(cur);
    PG8_STAGE(PG8_SB(0, 0), cB, voffB); PG8_STAGE(PG8_SB(0, 1), cB + hstepB, voffB); PG8_STAGE(PG8_SA(0, 0), cA, voffA); PG8_STAGE(PG8_SA(0, 1), cA + hstepA, voffA);
    if (wr == 1) PG8_BAR;
    PG8_WAIT_V(2); PG8_BAR;
    PG8_STAGE(PG8_SB(1, 0), cB + kstepB, voffB); PG8_STAGE(PG8_SA(1, 0), cA + kstepA, voffA); PG8_STAGE(PG8_SB(1, 1), cB + hstepB + kstepB, voffB);
    PG8_WAIT_V(6); PG8_BAR;
    for (;;) {
        const bool has_next = S.next(ui + 1, nxt);
        const char* nA = has_next ? L.a_ptr(nxt) : cA; const char* nB = has_next ? L.b_ptr(nxt) : cB;
#pragma unroll 1
        for (int t = 0; t < nt; t += 2) {
            const bool last = (t == nt - 2);
            const char* a1 = cA + (size_t)(t + 1) * kstepA;
            const char* a2 = last ? nA : cA + (size_t)(t + 2) * kstepA; const char* b2 = last ? nB : cB + (size_t)(t + 2) * kstepB;
            const char* a3 = a2 + kstepA; const char* b3 = b2 + kstepB;
            PG8_LDB(B0, 0, 0); PG8_LDB(B1, 0, 1); PG8_SCHED; PG8_LDA(At, 0, 0); PG8_STAGE(PG8_SA(1, 1), a1 + hstepA, voffA);
            PG8_WAIT_V(8); PG8_WAIT_L(0); PG8_BAR; PG8_MMA(0, 0, At, B0); PG8_MMA(0, 1, At, B1); PG8_BAR; PG8_SCHED;
            PG8_LDA(At, 0, 1); PG8_STAGE(PG8_SB(0, 0), b2, voffB); PG8_STAGE(PG8_SB(0, 1), b2 + hstepB, voffB); PG8_STAGE(PG8_SA(0, 0), a2, voffA);
            PG8_WAIT_V(8); PG8_WAIT_L(0); PG8_BAR; PG8_MMA(1, 0, At, B0); PG8_MMA(1, 1, At, B1); PG8_BAR; PG8_SCHED;
            PG8_LDB(B0, 1, 0); PG8_LDB(B1, 1, 1); PG8_SCHED; PG8_LDA(At, 1, 0); PG8_STAGE(PG8_SA(0, 1), a2 + hstepA, voffA);
            PG8_WAIT_V(8); PG8_WAIT_L(0); PG8_BAR; PG8_MMA(0, 0, At, B0); PG8_MMA(0, 1, At, B1); PG8_BAR; PG8_SCHED;
            PG8_LDA(At, 1, 1); PG8_STAGE(PG8_SB(1, 0), b3, voffB); PG8_STAGE(PG8_SB(1, 1), b3 + hstepB, voffB); PG8_STAGE(PG8_SA(1, 0), a3, voffA);
            PG8_WAIT_V(8); PG8_WAIT_L(0); PG8_BAR; PG8_MMA(1, 0, At, B0); PG8_MMA(1, 1, At, B1); PG8_BAR; PG8_SCHED;
        }
        if (wr == 0) PG8_BAR;
        { int fr2 = fr, fq2 = fq; asm volatile("" : "+v"(fr2), "+v"(fq2)); E(acc, cur, wr, wc, fr2, fq2); }
        if (!has_next) break;
#pragma unroll
        for (int a = 0; a < 2; ++a)
#pragma unroll
            for (int b = 0; b < 2; ++b)
#pragma unroll
                for (int m = 0; m < 4; ++m)
#pragma unroll
                    for (int n = 0; n < 2; ++n) acc[a][b][m][n] = (f32x4){0.f, 0.f, 0.f, 0.f};
        cur = nxt; cA = nA; cB = nB; ++ui;
        if (wr == 1) PG8_BAR;
    }
    PG8_WAIT_V(0);
    PG8_BAR;
#undef PG8_SA
#undef PG8_SB
#undef PG8_STAGE
#undef PG8_LDA
#undef PG8_LDB
#undef PG8_MMA
#undef PG8_WAIT_V
#undef PG8_WAIT_L
#undef PG8_BAR
#undef PG8_SCHED
}
}
struct MW {
    unsigned* ctl; float* MOD; float2* ROPE; float* CB;
    h16 *Wglu, *Wup0, *Wup1, *Wdn0, *Wdn1, *Wkv, *Wqg, *Wo, *Wc1k, *Wc1v;
    h16 *XH, *PBs16, *OUTH, *H16, *G16, *UP16, *ACT16, *HKV16, *KV16, *CMPP, *QP16, *QR16, *CMP16, *KC16p, *VC16p, *KC16s, *VC16s;
    float *OUTF, *GATE, *PBp, *PBs, *PART;
    float* out;
};
struct Args { const void* in[38]; MW w; int ph_lo, ph_hi; };
static_assert(sizeof(Args) % 8 == 0, "Args has no tail padding");

struct Frame {
    LAS unsigned char* lds; int wave, G, bid;
    __device__ __forceinline__ int lane() const { return lane_id(); }
    __device__ __forceinline__ int tid() const { return wave * 64 + lane_id(); }
};
#define INP(i) ((const float*)args.in[i])

constexpr int S5_BU = 128 * 144, S5_RS = 80, S5_WAVE_LDS = S5_BU + 128 * S5_RS;
__device__ __forceinline__ int colmap(int map, int n) {
    if (map == 0) return n;
    if (map == 1) { const int hb = n >> 6, j = n & 63; return hb * 64 + 4 * (j >> 3) + (j & 3) + 32 * ((j >> 2) & 1); }
      if (n < 1024) { const int hb = n >> 6, j = n & 63; return hb * 64 + 4 * (j >> 3) + (j & 3) + 32 * ((j >> 2) & 1); }
    return n < NQG ? n : -1;
}
__device__ __forceinline__ void tr_item(const float* W, int ldw, int K, h16* WT, int nblk, int map, int item, int lane) {
    const int kb = item / nblk, nb = item % nblk, n0 = 32 * nb, nl = lane & 31, kh = lane >> 5;
    const int nsrc = colmap(map, n0 + nl);
    const float* src = W + (size_t)(64 * kb + 32 * kh) * ldw + (nsrc >= 0 ? nsrc : 0);
    float v[32];
#pragma unroll
    for (int i = 0; i < 32; ++i) v[i] = src[(size_t)i * ldw];
    h16* dst = WT + (size_t)(n0 + nl) * K + 64 * kb + 32 * kh;
#pragma unroll
    for (int c = 0; c < 4; ++c) { u32x4 o;
        if (nsrc >= 0) { o.x = pkh(v[8 * c], v[8 * c + 1]); o.y = pkh(v[8 * c + 2], v[8 * c + 3]); o.z = pkh(v[8 * c + 4], v[8 * c + 5]); o.w = pkh(v[8 * c + 6], v[8 * c + 7]); } else o = (u32x4){0u, 0u, 0u, 0u};
        *(u32x4*)(dst + 8 * c) = o; }
}
__device__ __forceinline__ void sincos_d(double x, double& s, double& c) {
    const double k = rint(x * 0.63661977236758134308);
    double r = fma(-k, 1.57079632679489655800e+00, x);
    r = fma(-k, 6.12323399573676603587e-17, r);
    const double r2 = r * r;
    double ps = -1.0 / 1307674368000.0;
    ps = fma(ps, r2, 1.0 / 6227020800.0); ps = fma(ps, r2, -1.0 / 39916800.0); ps = fma(ps, r2, 1.0 / 362880.0); ps = fma(ps, r2, -1.0 / 5040.0);
    ps = fma(ps, r2, 1.0 / 120.0); ps = fma(ps, r2, -1.0 / 6.0); ps = fma(ps, r2, 1.0);
    const double sr = ps * r;
    double pc = 1.0 / 20922789888000.0;
    pc = fma(pc, r2, -1.0 / 87178291200.0); pc = fma(pc, r2, 1.0 / 479001600.0); pc = fma(pc, r2, -1.0 / 3628800.0); pc = fma(pc, r2, 1.0 / 40320.0);
    pc = fma(pc, r2, -1.0 / 720.0); pc = fma(pc, r2, 1.0 / 24.0); pc = fma(pc, r2, -0.5);
    const double cr = fma(pc, r2, 1.0);
    const int q = ((int)k) & 3;
    s = (q == 0) ? sr : (q == 1) ? cr : (q == 2) ? -sr : -cr;
    c = (q == 0) ? cr : (q == 1) ? -sr : (q == 2) ? -cr : sr;
}

__device__ __forceinline__ void adaln_item(const Frame& F, const Args& args, int item) {
    const int l = F.lane(), r = l & 31, h = l >> 5, cg = F.wave >> 2, kq = F.wave & 3;
    const int col0 = item * 64 + cg * 32;
    const float* W; int ld;
    if (col0 < 12288) { const int m = col0 / 3072; W = INP(12) + (size_t)m * D * 3072 + (col0 - m * 3072); ld = 3072; } else { W = INP(29) + (col0 - 12288); ld = 2048; }
    const float* c0 = r < BP ? INP(8) + r * D : INP(9) + (r - BP) * D;
    const float* c1 = INP(9) + (24 + (r & 7)) * D;
    f32x16 acc0 = {0.f, 0.f, 0.f, 0.f, 0.f, 0.f, 0.f, 0.f, 0.f, 0.f, 0.f, 0.f, 0.f, 0.f, 0.f, 0.f}, acc1 = acc0;
    for (int ks = 0; ks < 16; ks += 2) {
        float wv[2][8]; f32x4 ca[2][2], cb[2][2];
#pragma unroll
        for (int u = 0; u < 2; ++u) { const int k0 = 256 * kq + 16 * (ks + u) + 8 * h;
#pragma unroll
            for (int j = 0; j < 8; ++j) wv[u][j] = W[(size_t)(k0 + j) * ld + r];
            ca[u][0] = *(const f32x4*)(c0 + k0); ca[u][1] = *(const f32x4*)(c0 + k0 + 4); cb[u][0] = *(const f32x4*)(c1 + k0); cb[u][1] = *(const f32x4*)(c1 + k0 + 4); }
#pragma unroll
        for (int u = 0; u < 2; ++u) { h8v a0, a1, bf;
#pragma unroll
            for (int j = 0; j < 8; ++j) { const float x0 = ca[u][j >> 2][j & 3], x1 = cb[u][j >> 2][j & 3]; a0[j] = (h16)silu(x0); a1[j] = (h16)(r < 8 ? silu(x1) : 0.f); bf[j] = (h16)wv[u][j]; }
            acc0 = __builtin_amdgcn_mfma_f32_32x32x16_f16(a0, bf, acc0, 0, 0, 0); acc1 = __builtin_amdgcn_mfma_f32_32x32x16_f16(a1, bf, acc1, 0, 0, 0); }
    }
    LAS float* red = (LAS float*)F.lds + (cg * 4 + kq) * 1280;
#pragma unroll
    for (int reg = 0; reg < 16; ++reg) red[((reg & 3) + 8 * (reg >> 2) + 4 * h) * 32 + r] = acc0[reg];
#pragma unroll
    for (int reg = 0; reg < 4; ++reg) red[(32 + reg + 4 * h) * 32 + r] = acc1[reg];
    __syncthreads();
    for (int o = F.tid(); o < 2 * 1280; o += NT) { const int g2 = o / 1280, rc = o % 1280, row = rc >> 5, cc = rc & 31; const LAS float* q = (const LAS float*)F.lds + g2 * 4 * 1280 + rc;
        const float sum = (q[0] + q[1280]) + (q[2560] + q[3840]); const int c2 = item * 64 + g2 * 32 + cc;
        args.w.MOD[(size_t)row * MODW + c2] = sum + (c2 < 12288 ? INP(13)[c2] : INP(30)[c2 - 12288]); }
    __syncthreads();
}

__device__ __forceinline__ void p0_prep(const Frame& F, const Args& args) {
    const MW& w = args.w;
    if (F.bid < MODW / 64) adaln_item(F, args, F.bid);
    for (int id = F.bid * NT + F.tid(); id < NROPE * 32; id += F.G * NT) {
        const int idx = id >> 5, i = id & 31;
        const double pos = idx < LP ? (double)idx : (double)(PAST + idx - LP);
        double f = 1.0; for (int j = 0; j < i; ++j) f *= 0.74989420933245582730;
        double s, c; sincos_d(pos * f, s, c);
        w.ROPE[id] = make_float2((float)c, (float)s);
    }
    for (int o = F.bid; o < 256; o += F.G) {
        const int slot = o >> 7, h = o & 127; const float* pe = INP(32) + slot * 2048; const float* w1 = INP(33) + (size_t)slot * 2048 * 128 + h;
        float a = 0.f;
#pragma unroll
        for (int i = 0; i < 4; ++i) { const int k = F.tid() + NT * i; a += pe[k] * w1[(size_t)k * 128]; }
        a = wsum(a);
        LAS float* red = (LAS float*)(F.lds + 131072);
        __syncthreads();
        if (F.lane() == 0) red[F.wave] = a;
        __syncthreads();
        if (F.tid() == 0) { float t = INP(34)[o]; for (int ww = 0; ww < NW; ++ww) t += red[ww]; w.CB[o] = t; }
    }
}

struct RowPass {
    const float* xa; const float* xb;
    const h16* xh; h16* XHout;
    const h16* O; const float* wpost; int gate_off;
    const float* part; int nsplit; const h16* glu_g; const float* glu_b;
    float* Xout;
    const float* w1; int sh1; h16* H1;
    const float* w2; int sh2; h16* H2;
};
struct RowData { f32x4 x[2][4]; h4v o[2][4]; };
constexpr int F_XH = 1, F_O = 2, F_PART = 4, F_GLU = 8, F_XOUT = 16, F_XHOUT = 32, F_H1 = 64, F_H2 = 128;
template <int FL, int NSPLIT, bool SAMPLE, int NR>
__device__ __forceinline__ void row_load(const RowPass& P, int row, int lane, RowData& d) {
    if (FL & F_XH) {
#pragma unroll
        for (int q = 0; q < NR; ++q)
#pragma unroll
            for (int j = 0; j < 4; ++j) { const h4v v = *(const h4v*)(P.xh + (size_t)(row + q) * D + 4 * lane + 256 * j); d.x[q][j] = (f32x4){(float)v[0], (float)v[1], (float)v[2], (float)v[3]}; }
    } else {
        const float* xr = row < RP ? P.xa + (size_t)row * D : P.xb + (size_t)(row - RP) * D;
#pragma unroll
        for (int q = 0; q < NR; ++q)
#pragma unroll
            for (int j = 0; j < 4; ++j) d.x[q][j] = *(const f32x4*)(xr + (size_t)q * D + 4 * lane + 256 * j);
    }
    if ((FL & F_O) && !(SAMPLE && (FL & F_PART))) {
#pragma unroll
        for (int q = 0; q < NR; ++q)
#pragma unroll
            for (int j = 0; j < 4; ++j) d.o[q][j] = *(const h4v*)(P.O + (size_t)(row + q) * D + 4 * lane + 256 * j);
    }
}
template <int FL, int NSPLIT, bool SAMPLE, int NR>
__device__ __forceinline__ void row_body(const RowPass& P, const float* MOD, const int row, const int lane, const RowData& cur) {
    const float* m = MOD + (size_t)modrow(row) * MODW;
    f32x4 wp[4], gt[4], nw[4], sh[4], sc[4];
#define ROW_PARAMS() _Pragma("unroll") for (int j = 0; j < 4; ++j) { const int c = 4 * lane + 256 * j; \
        if (FL & F_O) { wp[j] = *(const f32x4*)(P.wpost + c); gt[j] = *(const f32x4*)(m + P.gate_off + c); } \
        if (FL & F_H1) { nw[j] = *(const f32x4*)(P.w1 + c); sh[j] = *(const f32x4*)(m + P.sh1 + c); sc[j] = *(const f32x4*)(m + P.sh1 + 1024 + c); } }
    if (!(SAMPLE && (FL & F_PART))) { ROW_PARAMS() }
    f32x4 x[NR][4];
#pragma unroll
    for (int q = 0; q < NR; ++q)
#pragma unroll
        for (int j = 0; j < 4; ++j) x[q][j] = cur.x[q][j];
    if (FL & F_O) {
        f32x4 o[NR][4]; float ss[NR];
#pragma unroll
        for (int q = 0; q < NR; ++q) {
            ss[q] = 0.f;
            if (!(SAMPLE && (FL & F_PART))) {
#pragma unroll
                for (int j = 0; j < 4; ++j) { const h4v ov = cur.o[q][j]; o[q][j] = (f32x4){(float)ov[0], (float)ov[1], (float)ov[2], (float)ov[3]}; }
            } else {
#pragma unroll
                for (int j = 0; j < 4; ++j) o[q][j] = (f32x4){0.f, 0.f, 0.f, 0.f};
#pragma unroll 1
                for (int sp0 = 0; sp0 < NSPLIT; sp0 += 4) {
                    f32x4 t[4][4];
#pragma unroll
                    for (int u = 0; u < 4; ++u)
#pragma unroll
                        for (int j = 0; j < 4; ++j) { const int sp = sp0 + u < NSPLIT ? sp0 + u : 0; t[u][j] = *(const f32x4*)(P.part + ((size_t)sp * 256 + (row + q - RP)) * D + 4 * lane + 256 * j); }
#pragma unroll
                    for (int u = 0; u < 4; ++u)
#pragma unroll
                        for (int j = 0; j < 4; ++j) { const float k = sp0 + u < NSPLIT ? 1.f : 0.f; o[q][j] += t[u][j] * k; }
                }
                if (FL & F_GLU) {
#pragma unroll
                    for (int j = 0; j < 4; ++j) { const int c = 4 * lane + 256 * j; const h4v g = *(const h4v*)(P.glu_g + (size_t)(row + q) * D + c); const f32x4 bb = *(const f32x4*)(P.glu_b + c); f32x4 a = o[q][j];
                        a[0] = (float)g[0] * sigm(a[0] + bb[0]); a[1] = (float)g[1] * sigm(a[1] + bb[1]); a[2] = (float)g[2] * sigm(a[2] + bb[2]); a[3] = (float)g[3] * sigm(a[3] + bb[3]); o[q][j] = a; }
                }
            }
#pragma unroll
            for (int j = 0; j < 4; ++j) ss[q] += o[q][j][0] * o[q][j][0] + o[q][j][1] * o[q][j][1] + o[q][j][2] * o[q][j][2] + o[q][j][3] * o[q][j][3];
        }
        if (SAMPLE && (FL & F_PART)) { ROW_PARAMS() }
        float rr[NR];
#pragma unroll
        for (int q = 0; q < NR; ++q) rr[q] = rsqrtf(wsum(ss[q]) * (1.f / D) + EPS);
#pragma unroll
        for (int j = 0; j < 4; ++j)
#pragma unroll
            for (int q = 0; q < NR; ++q) x[q][j] += gt[j] * (o[q][j] * rr[q] * wp[j]);
    }
    if (FL & F_XOUT) {
#pragma unroll
        for (int q = 0; q < NR; ++q)
#pragma unroll
            for (int j = 0; j < 4; ++j) *(f32x4*)(P.Xout + (size_t)(row + q) * D + 4 * lane + 256 * j) = x[q][j];
    }
    if (FL & F_XHOUT) {
#pragma unroll
        for (int q = 0; q < NR; ++q)
#pragma unroll
            for (int j = 0; j < 4; ++j) *(u32x2*)(P.XHout + (size_t)(row + q) * D + 4 * lane + 256 * j) = pkh4(x[q][j]);
    }
    if (FL & F_H1) {
        float rr[NR];
#pragma unroll
        for (int q = 0; q < NR; ++q) { float ss = 0.f;
#pragma unroll
            for (int j = 0; j < 4; ++j) ss += x[q][j][0] * x[q][j][0] + x[q][j][1] * x[q][j][1] + x[q][j][2] * x[q][j][2] + x[q][j][3] * x[q][j][3];
            rr[q] = rsqrtf(wsum(ss) * (1.f / D) + EPS); }
#pragma unroll
        for (int j = 0; j < 4; ++j) { const int c = 4 * lane + 256 * j;
#pragma unroll
            for (int q = 0; q < NR; ++q) *(u32x2*)(P.H1 + (size_t)(row + q) * D + c) = pkh4(x[q][j] * rr[q] * nw[j] * (1.f + sc[j]) + sh[j]); }
        if (FL & F_H2) {
#pragma unroll
            for (int j = 0; j < 4; ++j) { const int c = 4 * lane + 256 * j; nw[j] = *(const f32x4*)(P.w2 + c); sh[j] = *(const f32x4*)(m + P.sh2 + c); sc[j] = *(const f32x4*)(m + P.sh2 + 1024 + c); }
#pragma unroll
            for (int j = 0; j < 4; ++j) { const int c = 4 * lane + 256 * j;
#pragma unroll
                for (int q = 0; q < NR; ++q) *(u32x2*)(P.H2 + (size_t)(row + q) * D + c) = pkh4(x[q][j] * rr[q] * nw[j] * (1.f + sc[j]) + sh[j]); }
        }
    }
}
#undef ROW_PARAMS
template <int FL, int NSPLIT>
__device__ __forceinline__ void row_pass(const Frame& F, const float* MOD, const RowPass& P) {
    const int gw = F.bid * NW + F.wave, NGW = F.G * NW, lane = F.lane();
    if (FL & F_PART) {
        const int gs = (gw & 7) * (NGW >> 3) + (gw >> 3);
        for (int s = gs; s < RS; s += NGW) { RowData d; row_load<FL, NSPLIT, true, 1>(P, RP + s, lane, d); row_body<FL, NSPLIT, true, 1>(P, MOD, RP + s, lane, d); }
    }
    constexpr int NP = (FL & F_PART) ? RP / 2 : R / 2;
    RowData cur, nxt;
    row_load<FL, NSPLIT, false, 2>(P, 2 * (gw < NP ? gw : NP - 1), lane, cur);
#pragma unroll
    for (int q = 0; q < 2; ++q)
#pragma unroll
        for (int j = 0; j < 4; ++j) { asm volatile("" : "+v"(cur.x[q][j])); if (FL & F_O) asm volatile("" : "+v"(cur.o[q][j])); }
#pragma unroll 1
    for (int rp = gw; rp < NP; rp += NGW) {
        const int rn = rp + NGW < NP ? rp + NGW : NP - 1;
        row_load<FL, NSPLIT, false, 2>(P, 2 * rn, lane, nxt);
        row_body<FL, NSPLIT, false, 2>(P, MOD, 2 * rp, lane, cur);
        cur = nxt;
    }
}

constexpr int CW_BGQ = 640;
template <int MODE = 0>
__device__ __forceinline__ void bg_work(const Frame& F, const Args& args) {
    const MW& w = args.w; const float* cache = INP(2); const int* ptab = (const int*)args.in[7]; const int lane = F.lane();
    constexpr int I_GLU = 16 * 32, I_UP = 16 * 176, I_DN = 44 * 32, I_KV = 16 * 48, I_QG = 16 * 40, I_WO = 16 * 32, I_C1 = 16 * 4;
    constexpr int NITEMS = I_GLU + 2 * I_UP + 2 * I_DN + I_KV + I_QG + I_WO + 4 * I_C1, NCONV = BS * PAST / 8;
    constexpr int GRP = 8, NG_T = (NITEMS + GRP - 1) / GRP, NG_C = NCONV / GRP;
    for (int sgi = F.wave * F.G + F.bid;; sgi += 8 * F.G) {
        int gi = 0;
        if (MODE == 1) { gi = sgi; if (gi >= NG_T) break; }
        else { if (lane == 0) gi = (int)__hip_atomic_fetch_add(w.ctl + CW_BGQ, 1u, __ATOMIC_RELAXED, __HIP_MEMORY_SCOPE_AGENT);
               gi = __builtin_amdgcn_readfirstlane(gi);
               if (gi >= NG_T + NG_C) break;
               if (MODE == 2 && gi < NG_T) continue; }
      for (int sub = 0; sub < GRP; ++sub) {
        const int it = gi < NG_T ? gi * GRP + sub : NITEMS + (gi - NG_T) * GRP + sub;
        if (gi < NG_T && it >= NITEMS) break;
        if (it >= NITEMS) {
            const int rp0 = (it - NITEMS) * 8;
            f32x4 v0[8], v1[8];
#pragma unroll
            for (int q = 0; q < 8; ++q) { const int rp = rp0 + q, b = rp >> 13, pos = rp & (PAST - 1);
                const float* src = cache + ((size_t)ptab[b * NPAGES + (pos >> 7)] * PAGE + (pos & 127)) * 1024 + lane * 4; v0[q] = __builtin_nontemporal_load((const f32x4*)src); v1[q] = __builtin_nontemporal_load((const f32x4*)(src + 256)); }
#pragma unroll
            for (int q = 0; q < 8; ++q) {
                const int rp = rp0 + q, b = rp >> 13, pos = rp & (PAST - 1), c = pos >> 4, kt = pos & 15, pm = b * 8 + (c >> 6), row = (c & 63) * 4 + (lane >> 4);
                h16* dst = w.CMP16 + ((((size_t)pm * 16 + kt) * 256 + row) * 64 + 4 * (lane & 15));
                __builtin_nontemporal_store((u32x2){pkh(v0[q][0], v0[q][1]), pkh(v0[q][2], v0[q][3])}, (u32x2*)dst); __builtin_nontemporal_store((u32x2){pkh(v1[q][0], v1[q][1]), pkh(v1[q][2], v1[q][3])}, (u32x2*)(dst + (size_t)256 * 16 * 256 * 64)); }
            continue;
        }
        int r = it;
        if (r < I_GLU) { tr_item(INP(22), D, D, w.Wglu, 32, 0, r, lane); continue; } r -= I_GLU;
        if (r < I_UP) { tr_item(INP(24), F2, D, w.Wup0, 176, 0, r, lane); continue; } r -= I_UP;
        if (r < I_UP) { tr_item(INP(24) + (size_t)D * F2, F2, D, w.Wup1, 176, 0, r, lane); continue; } r -= I_UP;
        if (r < I_DN) { tr_item(INP(27), D, FF, w.Wdn0, 32, 0, r, lane); continue; } r -= I_DN;
        if (r < I_DN) { tr_item(INP(27) + (size_t)FF * D, D, FF, w.Wdn1, 32, 0, r, lane); continue; } r -= I_DN;
        if (r < I_KV) { tr_item(INP(31), NKV, D, w.Wkv, 48, 1, r, lane); continue; } r -= I_KV;
        if (r < I_QG) { tr_item(INP(36), NQG, D, w.Wqg, 40, 2, r, lane); continue; } r -= I_QG;
        if (r < I_WO) { tr_item(INP(37), D, D, w.Wo, 32, 0, r, lane); continue; } r -= I_WO;
        { const int q = r / I_C1, rr = r % I_C1, slot = q >> 1, half = q & 1;
          tr_item(INP(33) + (size_t)slot * 2048 * 128 + (size_t)half * 1024 * 128, 128, 1024, (slot ? w.Wc1v : w.Wc1k) + (size_t)half * 128 * 1024, 4, 0, rr, lane); }
      }
    }
}
__device__ __forceinline__ void s5_disc(const float* lam_re, const float* lam_im, int g, int p, double dt, float& are, float& aim, double& zre, double& zim) {
    const double lr = lam_re[g * P + p], li = lam_im[g * P + p];
    const double mag = exp(lr * dt); double sn, cs; sincos_d(li * dt, sn, cs);
    const double ar = mag * cs, ai = mag * sn, den = lr * lr + li * li;
    zre = ((ar - 1.0) * lr + ai * li) / den; zim = (ai * lr - (ar - 1.0) * li) / den; are = (float)ar; aim = (float)ai;
}
template <bool FULL>
__device__ __forceinline__ void s5_chunk(const h8v (&bf)[4], const h8v (&cf)[4], const f32x4 dsk, const float are, const float aim, float& sr, float& si,
                                         LAS float* BU, LAS unsigned char* S16, const h8v uf, const h4v hv0, const h4v hv1, const int nvalid, h16* gout, const int l) {
    const int r = l & 31, h = l >> 5, q4 = l >> 4, fr = l & 15;
    f32x16 acc[4];
#pragma unroll
    for (int nt = 0; nt < 4; ++nt) { const f32x16 z = {0.f, 0.f, 0.f, 0.f, 0.f, 0.f, 0.f, 0.f, 0.f, 0.f, 0.f, 0.f, 0.f, 0.f, 0.f, 0.f}; acc[nt] = __builtin_amdgcn_mfma_f32_32x32x16_f16(uf, bf[nt], z, 0, 0, 0); }
#pragma unroll
    for (int nt = 0; nt < 4; ++nt)
#pragma unroll
        for (int rg = 0; rg < 4; ++rg) *(LAS f32x4*)(BU + (32 * nt + r) * 36 + 8 * rg + 4 * h) = (f32x4){acc[nt][4 * rg], acc[nt][4 * rg + 1], acc[nt][4 * rg + 2], acc[nt][4 * rg + 3]};
    float xr[32], xi[32];
#pragma unroll
    for (int i = 0; i < 8; ++i) { const f32x4 a = *(const LAS f32x4*)(BU + l * 36 + 4 * i), b = *(const LAS f32x4*)(BU + (64 + l) * 36 + 4 * i);
        xr[4 * i] = a[0]; xr[4 * i + 1] = a[1]; xr[4 * i + 2] = a[2]; xr[4 * i + 3] = a[3]; xi[4 * i] = b[0]; xi[4 * i + 1] = b[1]; xi[4 * i + 2] = b[2]; xi[4 * i + 3] = b[3]; }
#pragma unroll
    for (int t = 0; t < 32; ++t) {
        if (FULL || t < nvalid) { const float t1 = __builtin_fmaf(-aim, si, xr[t]), t2 = __builtin_fmaf(aim, sr, xi[t]); const float nr = __builtin_fmaf(are, sr, t1), ni = __builtin_fmaf(are, si, t2); sr = nr; si = ni; }
        xr[t] = sr; xi[t] = si; }
#pragma unroll
    for (int i = 0; i < 4; ++i) { u32x4 a, b;
        a.x = pkh(xr[8 * i], xr[8 * i + 1]); a.y = pkh(xr[8 * i + 2], xr[8 * i + 3]); a.z = pkh(xr[8 * i + 4], xr[8 * i + 5]); a.w = pkh(xr[8 * i + 6], xr[8 * i + 7]);
        b.x = pkh(xi[8 * i], xi[8 * i + 1]); b.y = pkh(xi[8 * i + 2], xi[8 * i + 3]); b.z = pkh(xi[8 * i + 4], xi[8 * i + 5]); b.w = pkh(xi[8 * i + 6], xi[8 * i + 7]);
        *(LAS u32x4*)(S16 + l * S5_RS + 16 * i) = a; *(LAS u32x4*)(S16 + (64 + l) * S5_RS + 16 * i) = b; }
#pragma unroll
    for (int tt = 0; tt < 2; ++tt) {
        f32x4 y = {0.f, 0.f, 0.f, 0.f};
#pragma unroll
        for (int ks = 0; ks < 4; ++ks) {
            LAS unsigned char* pa = S16 + (32 * ks + 8 * q4 + (fr >> 2)) * S5_RS + (16 * tt + 4 * (fr & 3)) * 2;
            const s16x4 lo = __builtin_amdgcn_ds_read_tr16_b64_v4i16((LAS s16x4*)pa), hi = __builtin_amdgcn_ds_read_tr16_b64_v4i16((LAS s16x4*)(pa + 4 * S5_RS));
            const h8v sf = __builtin_bit_cast(h8v, (__attribute__((ext_vector_type(8))) short){lo[0], lo[1], lo[2], lo[3], hi[0], hi[1], hi[2], hi[3]});
            y = __builtin_amdgcn_mfma_f32_16x16x32_f16(cf[ks], sf, y, 0, 0, 0);
        }
        if (FULL || 16 * tt + fr < nvalid) {
            const h4v hv = tt ? hv1 : hv0;
            f32x4 v;
#pragma unroll
            for (int j = 0; j < 4; ++j) v[j] = gelu_t(y[j] + dsk[j] * (float)hv[j]);
            *(u32x2*)(gout + (16 * tt + fr) * D + 4 * q4) = pkh4(v);
        }
    }
}
template <bool FULL>
__device__ __forceinline__ void s5_item(const Frame& F, const Args& args, int seq, int g, LAS unsigned char* wl) {
    const MW& w = args.w; const int l = F.lane(), r = l & 31, h = l >> 5, q4 = l >> 4, fr = l & 15;
    const double dt = exp((double)INP(16)[g]);
    float are1, aim1, are2, aim2; double zre1, zim1, zre2, zim2;
    s5_disc(INP(14), INP(15), g, r, dt, are1, aim1, zre1, zim1);
    s5_disc(INP(14), INP(15), g, r + 32, dt, are2, aim2, zre2, zim2);
    const float are = h ? are2 : are1, aim = h ? aim2 : aim1;
    h8v bf[4];
#pragma unroll
    for (int nt = 0; nt < 4; ++nt) { const int p = (nt & 1) ? r + 32 : r; const double zr = (nt & 1) ? zre2 : zre1, zi = (nt & 1) ? zim2 : zim1;
        const float* br = INP(17) + (size_t)(g * P + p) * 16 + 8 * h; const float* bi = INP(18) + (size_t)(g * P + p) * 16 + 8 * h;
#pragma unroll
        for (int j = 0; j < 8; ++j) { const double v = (nt >> 1) ? (zr * bi[j] + zi * br[j]) : (zr * br[j] - zi * bi[j]); bf[nt][j] = (h16)(float)v; } }
    h8v cf[4];
#pragma unroll
    for (int ks = 0; ks < 4; ++ks) { const int p0 = 32 * (ks & 1) + 8 * q4; const float* src = ((ks >> 1) ? INP(20) : INP(19)) + (size_t)(g * 16 + fr) * P + p0;
#pragma unroll
        for (int j = 0; j < 8; ++j) cf[ks][j] = (h16)((ks >> 1) ? -src[j] : src[j]); }
    const f32x4 dsk = *(const f32x4*)(INP(21) + g * 16 + 4 * q4);
    float sr = 0.f, si = 0.f;
    LAS float* BU = (LAS float*)wl; LAS unsigned char* S16 = wl + S5_BU;
    if (FULL) {
        const h16* hb = w.H16 + (size_t)seq * LP * D + g * 16; h16* gb = w.G16 + (size_t)seq * LP * D + g * 16;
        const int oa = r * D + 8 * h, ob = fr * D + 4 * q4;
#define S5_LOAD(U, A, B, T) { const int tc = (T) < LP - 32 ? (T) : LP - 32; const h16* pp = hb + (size_t)tc * D; U = *(const h8v*)(pp + oa); A = *(const h4v*)(pp + ob); B = *(const h4v*)(pp + ob + 16 * D); asm volatile("" ::: "memory"); }
#define S5_CHUNK(U, A, B, T) { s5_chunk<true>(bf, cf, dsk, are, aim, sr, si, BU, S16, U, A, B, 32, gb + (size_t)(T) * D, l); asm volatile("" ::: "memory"); }
        h8v u0, u1, u2, u3; h4v a0, a1, a2, a3, b0, b1, b2, b3;
        S5_LOAD(u0, a0, b0, 0) S5_LOAD(u1, a1, b1, 32) S5_LOAD(u2, a2, b2, 64)
#pragma unroll 1
        for (int t0 = 0; t0 < LP; t0 += 128) {
            S5_LOAD(u3, a3, b3, t0 + 96)  S5_CHUNK(u0, a0, b0, t0)
            S5_LOAD(u0, a0, b0, t0 + 128) S5_CHUNK(u1, a1, b1, t0 + 32)
            S5_LOAD(u1, a1, b1, t0 + 160) S5_CHUNK(u2, a2, b2, t0 + 64)
            S5_LOAD(u2, a2, b2, t0 + 192) S5_CHUNK(u3, a3, b3, t0 + 96)
        }
#undef S5_LOAD
#undef S5_CHUNK
        w.out[O_SRE_P + (size_t)(seq * G + g) * P + l] = sr; w.out[O_SIM_P + (size_t)(seq * G + g) * P + l] = si;
    } else {
        const int sb = seq - BP, row0 = RP + sb * LS;
        sr = INP(4)[(sb * G + g) * P + l]; si = INP(5)[(sb * G + g) * P + l];
        h8v uf = {0, 0, 0, 0, 0, 0, 0, 0}; h4v hv0 = {0, 0, 0, 0};
        if (r < LS) uf = *(const h8v*)(w.H16 + (size_t)(row0 + r) * D + g * 16 + 8 * h);
        if (fr < LS) hv0 = *(const h4v*)(w.H16 + (size_t)(row0 + fr) * D + g * 16 + 4 * q4);
        s5_chunk<false>(bf, cf, dsk, are, aim, sr, si, BU, S16, uf, hv0, hv0, LS, w.G16 + (size_t)row0 * D + g * 16, l);
        w.out[O_SRE_S + (size_t)(sb * G + g) * P + l] = sr; w.out[O_SIM_S + (size_t)(sb * G + g) * P + l] = si;
    }
}
__device__ __forceinline__ void s5_phase(const Frame& F, const Args& args) {
#define BGW bg_work<0>
    if (F.wave >= 4) { BGW(F, args); return; }
    LAS unsigned char* wl = F.lds + F.wave * S5_WAVE_LDS;
    if (F.wave < 2) { for (int it = F.wave * F.G + F.bid; it < BP * G; it += 2 * F.G) s5_item<true>(F, args, it / G, it % G, wl); }
    else { for (int it = (F.wave - 2) * F.G + F.bid; it < BS * G; it += 2 * F.G) s5_item<false>(F, args, BP + it / G, it % G, wl); }
    BGW(F, args);
}
struct EpiGlu {
    static constexpr bool PERM = true;
    const h16* Gm; const float* bias; h16* O;
    __device__ __forceinline__ void operator()(const f32x4 (&acc)[2][2][4][2], const pg8::Unit& u, int wr, int wc, int fr, int fq) const {
        const int row0 = u.pm * 256 + wr * 64 + fr, col0 = u.pn * 256 + wc * 32 + 8 * fq;
        f32x4 bs[2][2];
#pragma unroll
        for (int bj = 0; bj < 2; ++bj) { bs[bj][0] = *(const f32x4*)(bias + col0 + bj * 128); bs[bj][1] = *(const f32x4*)(bias + col0 + bj * 128 + 4); }
#pragma unroll
        for (int ai = 0; ai < 2; ++ai) {
            h8v g[4][2];
#pragma unroll
            for (int m = 0; m < 4; ++m)
#pragma unroll
                for (int bj = 0; bj < 2; ++bj) g[m][bj] = *(const h8v*)(Gm + (size_t)(row0 + ai * 128 + m * 16) * D + col0 + bj * 128);
#pragma unroll
            for (int m = 0; m < 4; ++m) { const size_t ro = (size_t)(row0 + ai * 128 + m * 16) * D;
#pragma unroll
                for (int bj = 0; bj < 2; ++bj) { const int c = col0 + bj * 128; const h8v gg = g[m][bj];
                    const f32x4 v0 = acc[ai][bj][m][0] + bs[bj][0], v1 = acc[ai][bj][m][1] + bs[bj][1];
                    u32x4 w; w.x = pkh((float)gg[0] * sigm(v0[0]), (float)gg[1] * sigm(v0[1])); w.y = pkh((float)gg[2] * sigm(v0[2]), (float)gg[3] * sigm(v0[3]));
                    w.z = pkh((float)gg[4] * sigm(v1[0]), (float)gg[5] * sigm(v1[1])); w.w = pkh((float)gg[6] * sigm(v1[2]), (float)gg[7] * sigm(v1[3]));
                    *(u32x4*)(O + ro + c) = w; } }
        }
    }
};
struct EpiH16 {
    static constexpr bool PERM = true;
    h16* O; int ldc;
    __device__ __forceinline__ void operator()(const f32x4 (&acc)[2][2][4][2], const pg8::Unit& u, int wr, int wc, int fr, int fq) const {
        const int row0 = u.pm * 256 + wr * 64 + fr, col0 = u.pn * 256 + wc * 32 + 8 * fq;
#pragma unroll
        for (int ai = 0; ai < 2; ++ai)
#pragma unroll
            for (int m = 0; m < 4; ++m) { h16* rp = O + (size_t)(row0 + ai * 128 + m * 16) * ldc + col0;
#pragma unroll
                for (int bj = 0; bj < 2; ++bj) { const f32x4 v0 = acc[ai][bj][m][0], v1 = acc[ai][bj][m][1];
                    u32x4 w; w.x = pkh(v0[0], v0[1]); w.y = pkh(v0[2], v0[3]); w.z = pkh(v1[0], v1[1]); w.w = pkh(v1[2], v1[3]);
                    *(u32x4*)(rp + bj * 128) = w; } }
    }
};
struct EpiUp {
    static constexpr bool PERM = true;
    h16* O; float* cp; float* cs;
    __device__ __forceinline__ void operator()(const f32x4 (&acc)[2][2][4][2], const pg8::Unit& u, int wr, int wc, int fr, int fq) const {
        const int row0 = u.pm * 256 + wr * 64 + fr, col0 = u.pn * 256 + wc * 32 + 8 * fq;
#pragma unroll
        for (int ai = 0; ai < 2; ++ai)
#pragma unroll
            for (int m = 0; m < 4; ++m) { const int row = row0 + ai * 128 + m * 16; h16* rp = O + (size_t)row * F2 + col0;
                float* st = nullptr;
                if (row < RP) { const int t = row & (LP - 1); if (t >= LP - 2) st = cp + ((size_t)(row >> 11) * 2 + (t - (LP - 2))) * F2 + col0; }
                else { const int t = (row - RP) & 7; if (t >= LS - 2) st = cs + ((size_t)((row - RP) >> 3) * 2 + (t - (LS - 2))) * F2 + col0; }
#pragma unroll
                for (int bj = 0; bj < 2; ++bj) { const f32x4 v0 = acc[ai][bj][m][0], v1 = acc[ai][bj][m][1];
                    u32x4 w; w.x = pkh(v0[0], v0[1]); w.y = pkh(v0[2], v0[3]); w.z = pkh(v1[0], v1[1]); w.w = pkh(v1[2], v1[3]);
                    *(u32x4*)(rp + bj * 128) = w;
                    if (st) { *(f32x4*)(st + bj * 128) = v0; *(f32x4*)(st + bj * 128 + 4) = v1; } } }
    }
};
struct EpiPart {
    static constexpr bool PERM = false;
    float* O;
    __device__ __forceinline__ void operator()(const f32x4 (&acc)[2][2][4][2], const pg8::Unit& u, int wr, int wc, int fr, int fq) const {
        int row0 = wr * 64 + fr; asm volatile("" : "+v"(row0));
        const int col0 = u.pn * 256 + wc * 32 + 4 * fq; float* base = O + (size_t)u.sub * 256 * 1024 + (unsigned)(row0 * 1024 + col0);
#pragma unroll
        for (int ai = 0; ai < 2; ++ai)
#pragma unroll
            for (int m = 0; m < 4; ++m) { float* rp = base + (ai * 128 + m * 16) * 1024;
#pragma unroll
                for (int bj = 0; bj < 2; ++bj)
#pragma unroll
                    for (int n = 0; n < 2; ++n) *(f32x4*)(rp + bj * 128 + n * 16) = acc[ai][bj][m][n]; }
    }
};
__device__ __forceinline__ void conv_phase(const Frame& F, const Args& args, int layer) {
    const MW& w = args.w;
    constexpr int NCHUNK = FF / 8;
    const int ch = F.tid();
    if (ch >= NCHUNK) return;
    const float* cw = (const float*)args.in[25] + (size_t)layer * 3 * F2; const float* cb = (const float*)args.in[26] + (size_t)layer * F2;
    const float* prefix = (const float*)args.in[6] + (size_t)layer * BS * 2 * F2;
    const int j0 = ch * 8;
    float wa[3][8], wg[3][8], ba[8], bg[8];
#pragma unroll
    for (int k = 0; k < 3; ++k)
#pragma unroll
        for (int e = 0; e < 8; ++e) { wa[k][e] = cw[k * F2 + j0 + e]; wg[k][e] = cw[k * F2 + FF + j0 + e]; }
#pragma unroll
    for (int e = 0; e < 8; ++e) { ba[e] = cb[j0 + e]; bg[e] = cb[FF + j0 + e]; }
    constexpr int NSEG_P = RP / 64, NSEG = NSEG_P + BS;
    for (int seg = F.bid; seg < NSEG; seg += F.G) {
        int jj = j0; asm volatile("" : "+v"(jj));
        int row0, nrows; h8v p0a, p1a, p0g, p1g;
        if (seg < NSEG_P) {
            row0 = seg * 64; nrows = 64; const int t0 = row0 & (LP - 1);
            if (t0 == 0) {
#pragma unroll
                for (int e = 0; e < 8; ++e) { p0a[e] = 0; p1a[e] = 0; p0g[e] = 0; p1g[e] = 0; }
            } else {
                p0a = *(const h8v*)(w.UP16 + (size_t)(row0 - 2) * F2 + jj); p1a = *(const h8v*)(w.UP16 + (size_t)(row0 - 1) * F2 + jj);
                p0g = *(const h8v*)(w.UP16 + (size_t)(row0 - 2) * F2 + FF + jj); p1g = *(const h8v*)(w.UP16 + (size_t)(row0 - 1) * F2 + FF + jj);
            }
        } else {
            const int b = seg - NSEG_P; row0 = RP + b * LS; nrows = LS;
#pragma unroll
            for (int e = 0; e < 8; ++e) { p0a[e] = (h16)prefix[((size_t)b * 2 + 0) * F2 + jj + e]; p1a[e] = (h16)prefix[((size_t)b * 2 + 1) * F2 + jj + e];
                                          p0g[e] = (h16)prefix[((size_t)b * 2 + 0) * F2 + FF + jj + e]; p1g[e] = (h16)prefix[((size_t)b * 2 + 1) * F2 + FF + jj + e]; }
        }
        h8v ua[4], ug[4], na[4], ng[4];
#pragma unroll
        for (int q = 0; q < 4; ++q) { ua[q] = *(const h8v*)(w.UP16 + (size_t)(row0 + q) * F2 + jj); ug[q] = *(const h8v*)(w.UP16 + (size_t)(row0 + q) * F2 + FF + jj); }
#pragma unroll
        for (int q = 0; q < 4; ++q) { asm volatile("" : "+v"(ua[q])); asm volatile("" : "+v"(ug[q])); }
#pragma unroll 1
        for (int t = 0; t < nrows; t += 4) {
            { const int tn = t + 4 < nrows ? t + 4 : t;
#pragma unroll
                for (int q = 0; q < 4; ++q) { na[q] = *(const h8v*)(w.UP16 + (size_t)(row0 + tn + q) * F2 + jj); ng[q] = *(const h8v*)(w.UP16 + (size_t)(row0 + tn + q) * F2 + FF + jj); }
                asm volatile("" ::: "memory");
#pragma unroll
                for (int q = 0; q < 4; ++q) { asm volatile("" : "+v"(ua[q])); asm volatile("" : "+v"(ug[q])); }
            }
#pragma unroll
            for (int q = 0; q < 4; ++q) {
                float o[8];
                const h8v r0a = q >= 2 ? ua[q >= 2 ? q - 2 : 0] : (q == 1 ? p1a : p0a), r1a = q >= 1 ? ua[q >= 1 ? q - 1 : 0] : p1a;
                const h8v r0g = q >= 2 ? ug[q >= 2 ? q - 2 : 0] : (q == 1 ? p1g : p0g), r1g = q >= 1 ? ug[q >= 1 ? q - 1 : 0] : p1g;
#pragma unroll
                for (int e = 0; e < 8; ++e) { const float a2 = (float)ua[q][e], g2 = (float)ug[q][e];
                    const float ca = ba[e] + wa[0][e] * (float)r0a[e] + wa[1][e] * (float)r1a[e] + wa[2][e] * a2;
                    const float cg = bg[e] + wg[0][e] * (float)r0g[e] + wg[1][e] * (float)r1g[e] + wg[2][e] * g2;
                    o[e] = silu(cg) * ca; }
                u32x4 pk; pk.x = pkh(o[0], o[1]); pk.y = pkh(o[2], o[3]); pk.z = pkh(o[4], o[5]); pk.w = pkh(o[6], o[7]);
                *(u32x4*)(w.ACT16 + (size_t)(row0 + t + q) * FF + jj) = pk;
            }
            p0a = ua[2]; p1a = ua[3]; p0g = ug[2]; p1g = ug[3];
#pragma unroll
            for (int q = 0; q < 4; ++q) { ua[q] = na[q]; ug[q] = ng[q]; }
        }
    }
}

struct EpiKvQg {
    static constexpr bool PERM = true;
    const float2* ROPE; h16* KV16; h16* CMPP; float* out; h16* QP16; h16* QR16; float* GATE;
    __device__ __forceinline__ void operator()(const f32x4 (&acc)[2][2][4][2], const pg8::Unit& u, int wr, int wc, int fr, int fq) const {
        const int row0 = u.pm * 256 + wr * 64 + fr, col0 = u.pn * 256 + wc * 32 + 8 * fq;
        const int i0 = (col0 & 63) >> 1;
        const bool anyrope = u.sub != 0 || (u.pn >= 2 && u.pn < 5);
#pragma unroll
        for (int ai = 0; ai < 2; ++ai) {
            f32x4 rc[4][2];
            if (anyrope) {
#pragma unroll
                for (int m = 0; m < 4; ++m) { const float2* rp = ROPE + ropeidx(row0 + ai * 128 + m * 16) * 32 + i0; rc[m][0] = *(const f32x4*)rp; rc[m][1] = *(const f32x4*)(rp + 2); }
            }
#pragma unroll
            for (int m = 0; m < 4; ++m) { const int row = row0 + ai * 128 + m * 16;
                const f32x4 cv = {rc[m][0][0], rc[m][0][2], rc[m][1][0], rc[m][1][2]}, sv = {rc[m][0][1], rc[m][0][3], rc[m][1][1], rc[m][1][3]};
#pragma unroll
                for (int bj = 0; bj < 2; ++bj) { const int c = col0 + bj * 128; f32x4 a = acc[ai][bj][m][0], b = acc[ai][bj][m][1];                    const int hb = c >> 6;
                    if (u.sub == 0) {
                        const int s6 = hb >> 2, kvh = hb & 3;
                        if (s6 == 2 || s6 == 4) { const f32x4 ta = a * cv - b * sv, tb = b * cv + a * sv; a = ta; b = tb; }
                        if (s6 < 4) { float* o = out + O_ROWS + (size_t)row * 1024 + s6 * 256 + kvh * 64 + i0; *(f32x4*)o = a; *(f32x4*)(o + 32) = b; }
                        else { const int s2 = s6 - 4; float* o = nullptr;
                            if (row < RP) { const int t = row & (LP - 1); if (t >= LP - WIN) o = out + O_WIN_P + ((size_t)((row >> 11) * WIN + t - (LP - WIN)) * 2 + s2) * 256 + kvh * 64 + i0; }
                            else o = out + O_WIN_S + ((size_t)(row - RP) * 2 + s2) * 256 + kvh * 64 + i0;
                            if (o) { *(f32x4*)o = a; *(f32x4*)(o + 32) = b; } }
                        if (s6 >= 2) { h16* k = KV16 + (size_t)row * 1024 + (s6 - 2) * 256 + kvh * 64 + i0; *(u32x2*)k = pkh4(a); *(u32x2*)(k + 32) = pkh4(b); }
                        else if (row < RP) { h16* k = CMPP + (size_t)row * 512 + s6 * 256 + kvh * 64 + i0; *(u32x2*)k = pkh4(a); *(u32x2*)(k + 32) = pkh4(b); }
                    } else if (c < 1024) {
                        h16* qp = QP16 + (size_t)row * D + hb * 64 + i0; h16* qr = QR16 + (size_t)row * D + hb * 64 + i0;
                        constexpr float QS = 0.125f * 1.4426950408889634f;
                        *(u32x2*)qp = pkh4(a * QS); *(u32x2*)(qp + 32) = pkh4(b * QS);
                        *(u32x2*)qr = pkh4((a * cv - b * sv) * QS); *(u32x2*)(qr + 32) = pkh4((b * cv + a * sv) * QS);
                    } else if (c < NQG) {
                        f32x4 g0, g1;
#pragma unroll
                        for (int e = 0; e < 4; ++e) { g0[e] = sigm(a[e]); g1[e] = sigm(b[e]); }
                        float* gp = GATE + (size_t)row * 48 + (c - 1024); *(f32x4*)gp = g0; *(f32x4*)(gp + 4) = g1;
                    }
                } }
        }
    }
};
struct KvQgOrder {
    pg8::StaticOrder a, b; int G, c;
    __device__ void init(int G_, int c_) { G = G_; c = c_; a.init(R, NKV, 1, 0); b.init(R, 1280, 1, 0); }
    __device__ bool next(int i, pg8::Unit& u) const {
        const int L = i * G + c;
        if (L < a.nwg) { a.next(L, u); u.sub = 0; return true; }
        if (L < a.nwg + b.nwg) { b.next(L - a.nwg, u); u.sub = 1; return true; }
        return false;
    }
};
struct KvQgLay {
    const h16 *A0, *B0, *A1, *B1;
    __device__ __forceinline__ unsigned a_rowoff(int r) const { return (unsigned)r * 2048u; }
    __device__ __forceinline__ unsigned b_rowoff(int r) const { return (unsigned)r * 2048u; }
    __device__ __forceinline__ size_t a_kstep() const { return 128; }
    __device__ __forceinline__ const char* a_ptr(const pg8::Unit& u) const { return (const char*)(u.sub ? A1 : A0) + (size_t)u.pm * 256 * 2048; }
    __device__ __forceinline__ const char* b_ptr(const pg8::Unit& u) const { return (const char*)(u.sub ? B1 : B0) + (size_t)u.pn * 256 * 2048; }
};

struct CmpOrderS {
    int G, c;
    __device__ bool next(int i, pg8::Unit& u) const { const int L = i * G + c; if (L >= 512) return false; u.pn = 0; u.sub = L >> 8; u.pm = L & 255; return true; }
};
struct CmpOrderP {
    int G, c;
    __device__ bool next(int i, pg8::Unit& u) const { const int L = i * G + c; if (L >= 128) return false; u.pn = 0; const int rest = L >> 2; u.sub = (rest >> 4) + 2 * (L & 3); u.pm = rest & 15; return true; }
};
struct CmpLayS {
    const h16 *CS, *Wk, *Wv;
    __device__ __forceinline__ unsigned a_rowoff(int r) const { return (unsigned)r * 128u; }
    __device__ __forceinline__ unsigned b_rowoff(int r) const { return (unsigned)r * 2048u; }
    __device__ __forceinline__ size_t a_kstep() const { return 32768; }
    __device__ __forceinline__ const char* a_ptr(const pg8::Unit& u) const { return (const char*)(CS + ((size_t)((u.sub & 1) * 256 + u.pm) * 16) * 256 * 64); }
    __device__ __forceinline__ const char* b_ptr(const pg8::Unit& u) const { return (const char*)((u.sub & 1) ? Wv : Wk); }
};
struct CmpLayP {
    const h16 *CP, *Wk, *Wv;
    __device__ __forceinline__ unsigned a_rowoff(int r) const { return (unsigned)(r >> 2) * 16384u + (unsigned)(r & 3) * 128u; }
    __device__ __forceinline__ unsigned b_rowoff(int r) const { return (unsigned)r * 2048u; }
    __device__ __forceinline__ size_t a_kstep() const { return 1024; }
    __device__ __forceinline__ const char* a_ptr(const pg8::Unit& u) const { return (const char*)(CP + ((size_t)(u.pm >> 1) * LP + (size_t)(u.pm & 1) * 1024 + (size_t)(u.sub >> 1) * 4) * 512 + (u.sub & 1) * 256); }
    __device__ __forceinline__ const char* b_ptr(const pg8::Unit& u) const { return (const char*)((u.sub & 1) ? Wv : Wk) + (size_t)(u.sub >> 1) * 512; }
};
struct EpiCmpP {
    static constexpr bool PERM = false, AFTER_DRAIN = false;
    float* PB;
    __device__ __forceinline__ void operator()(const f32x4 (&acc)[2][2][4][2], const pg8::Unit& u, int wr, int wc, int fr, int fq) const {
        float* O = PB + (size_t)((u.sub >> 1) * 2 + (u.sub & 1)) * 4096 * 256;
        const int row0 = u.pm * 256 + wr * 64 + fr, col0 = wc * 32 + 4 * fq; float* ob = O + (size_t)row0 * 256 + col0;
#pragma unroll
        for (int ai = 0; ai < 2; ++ai)
#pragma unroll
            for (int m = 0; m < 4; ++m) { float* rp = ob + (ai * 128 + m * 16) * 256;
#pragma unroll
                for (int bj = 0; bj < 2; ++bj)
#pragma unroll
                    for (int n = 0; n < 2; ++n) *(f32x4*)(rp + bj * 128 + n * 16) = acc[ai][bj][m][n]; }
    }
};
struct EpiCmpS {
    static constexpr bool PERM = true, AFTER_DRAIN = false;
    h16* PB;
    __device__ __forceinline__ void operator()(const f32x4 (&acc)[2][2][4][2], const pg8::Unit& u, int wr, int wc, int fr, int fq) const {
        h16* ob = PB + (size_t)(u.sub & 1) * 65536 * 256 + (size_t)(u.pm * 256 + wr * 64 + fr) * 256 + wc * 32 + 8 * fq;
#pragma unroll
        for (int ai = 0; ai < 2; ++ai)
#pragma unroll
            for (int m = 0; m < 4; ++m) { h16* rp = ob + (ai * 128 + m * 16) * 256;
#pragma unroll
                for (int bj = 0; bj < 2; ++bj) { const f32x4 v0 = acc[ai][bj][m][0], v1 = acc[ai][bj][m][1];
                    u32x4 w; w.x = pkh(v0[0], v0[1]); w.y = pkh(v0[2], v0[3]); w.z = pkh(v1[0], v1[1]); w.w = pkh(v1[2], v1[3]);
                    *(u32x4*)(rp + bj * 128) = w; } }
    }
};
constexpr int C2_HST = 272;
__device__ __forceinline__ void cmp2_phase(const Frame& F, const Args& args) {
    const MW& w = args.w; const int l = F.lane(), r = l & 31, h2 = l >> 5;
    const int gw = F.bid * NW + F.wave, NGW = F.G * NW;
    constexpr int TP = BP * NC_P * 4 / 32, TS = BS * NC_S * 4 / 32;
    for (int f = F.tid(); f < 2 * 8 * 2 * 64; f += NT) {
        const int fl = f & 63, nt = (f >> 6) & 1, ks = (f >> 7) & 7, slot = f >> 10;
        const float* w2 = (const float*)args.in[35] + (size_t)slot * 128 * 64 + (size_t)(16 * ks + 8 * (fl >> 5)) * 64 + 32 * nt + (fl & 31);
        u32x4 o; o.x = pkh(w2[0], w2[64]); o.y = pkh(w2[128], w2[192]); o.z = pkh(w2[256], w2[320]); o.w = pkh(w2[384], w2[448]);
        *(LAS u32x4*)(F.lds + (size_t)f * 16) = o;
    }
    __syncthreads();
    LAS unsigned char* HL = F.lds + 32768 + F.wave * (32 * C2_HST);
    const int srow = l >> 4, sc = l & 15;
    for (int tile = gw; tile < 2 * (TP + TS); tile += NGW) {
        const int slot = tile >= TP + TS ? 1 : 0; const int t2 = tile - slot * (TP + TS);
        const bool samp = t2 >= TP; const int tl = samp ? t2 - TP : t2;
        const int nc = samp ? NC_S : NC_P, nch = samp ? 512 : 128;
        h16* KC = samp ? (slot ? w.VC16s : w.KC16s) : (slot ? w.VC16p : w.KC16p);
        const f32x4 c0 = *(const f32x4*)(w.CB + slot * 128 + sc * 8), c1 = *(const f32x4*)(w.CB + slot * 128 + sc * 8 + 4);
#pragma unroll
        for (int it = 0; it < 8; ++it) {
            const int rho = tl * 32 + it * 4 + srow;
            const int kvh = rho & 3, bi = rho >> 2, b = bi / nc, i = bi % nc;
            const size_t prow = ((size_t)(b * nch + i) * 4 + kvh) * 256 + sc * 8;
            f32x4 x0, x1;
            if (samp) { const h16* PBh = w.PBs16 + (size_t)slot * 65536 * 256 + prow; const h8v xa = *(const h8v*)PBh, ya = *(const h8v*)(PBh + 4 * 256 + 128);
#pragma unroll
                for (int j = 0; j < 4; ++j) { x0[j] = (float)xa[j] + (float)ya[j]; x1[j] = (float)xa[4 + j] + (float)ya[4 + j]; } }
            else { const float* p0 = w.PBp + (size_t)slot * 4096 * 256 + prow; const float* p1 = p0 + 4 * 256 + 128;
                x0 = *(const f32x4*)p0 + *(const f32x4*)p1; x1 = *(const f32x4*)(p0 + 4) + *(const f32x4*)(p1 + 4);
#pragma unroll
                for (int sl = 1; sl < 4; ++sl) { const size_t so = (size_t)sl * 2 * 4096 * 256; x0 += *(const f32x4*)(p0 + so) + *(const f32x4*)(p1 + so); x1 += *(const f32x4*)(p0 + so + 4) + *(const f32x4*)(p1 + so + 4); } }
            u32x4 hv; hv.x = pkh(gelu_t(x0[0] + c0[0]), gelu_t(x0[1] + c0[1])); hv.y = pkh(gelu_t(x0[2] + c0[2]), gelu_t(x0[3] + c0[3]));
            hv.z = pkh(gelu_t(x1[0] + c1[0]), gelu_t(x1[1] + c1[1])); hv.w = pkh(gelu_t(x1[2] + c1[2]), gelu_t(x1[3] + c1[3]));
            *(LAS u32x4*)(HL + (it * 4 + srow) * C2_HST + sc * 16) = hv;
        }
        const LAS unsigned char* wfp = F.lds + (size_t)slot * 16384 + l * 16;
        f32x16 acc0 = {0.f, 0.f, 0.f, 0.f, 0.f, 0.f, 0.f, 0.f, 0.f, 0.f, 0.f, 0.f, 0.f, 0.f, 0.f, 0.f}, acc1 = acc0;
#pragma unroll
        for (int ks = 0; ks < 8; ++ks) {
            const h8v hf = *(const LAS h8v*)(HL + r * C2_HST + (16 * ks + 8 * h2) * 2);
            const h8v b0 = *(const LAS h8v*)(wfp + (ks * 2 + 0) * 1024), b1 = *(const LAS h8v*)(wfp + (ks * 2 + 1) * 1024);
            acc0 = __builtin_amdgcn_mfma_f32_32x32x16_f16(hf, b0, acc0, 0, 0, 0);
            acc1 = __builtin_amdgcn_mfma_f32_32x32x16_f16(hf, b1, acc1, 0, 0, 0);
        }
#pragma unroll
        for (int rg = 0; rg < 16; ++rg) { const int orow = tl * 32 + (rg & 3) + 8 * (rg >> 2) + 4 * h2; KC[(size_t)orow * 64 + r] = (h16)acc0[rg]; KC[(size_t)orow * 64 + 32 + r] = (h16)acc1[rg]; }
    }
    __syncthreads();
}
__device__ __forceinline__ float ex2(float x) { return __builtin_amdgcn_exp2f(x); }
constexpr int AT_KST = 144, AT_KB = 64 * AT_KST, AT_VB = 8192, AT_BUF = AT_KB + AT_VB;
__device__ __forceinline__ int kaddr(int row, int c) { return row * AT_KST + c * 16; }
__device__ __forceinline__ constexpr int keyc(int kt, int reg) { return 32 * kt + (reg & 3) + 8 * (reg >> 2); }
__device__ __forceinline__ float xhalf(float v) { return __shfl_xor(v, 32); }
__device__ __forceinline__ void qk64(const LAS unsigned char* KT, const h8v (&qf)[4], f32x16 (&st)[2], int r, int h) {
#pragma unroll
    for (int kt = 0; kt < 2; ++kt) { f32x16 a = {0.f, 0.f, 0.f, 0.f, 0.f, 0.f, 0.f, 0.f, 0.f, 0.f, 0.f, 0.f, 0.f, 0.f, 0.f, 0.f};
#pragma unroll
        for (int ks = 0; ks < 4; ++ks) { const h8v kf = *(const LAS h8v*)(KT + (r * AT_KST + h * 16) + (32 * kt * AT_KST + 32 * ks)); a = __builtin_amdgcn_mfma_f32_32x32x16_f16(kf, qf[ks], a, 0, 0, 0); }
        st[kt] = a; }
}
__device__ __forceinline__ h8v vfrag(const LAS unsigned char* VT, int keybase, int dt, int l) {
    const int h = l >> 5, i = l & 15, q = i >> 2, p = i & 3;
    const LAS unsigned char* a = VT + ((4 * h + q) * 128 + (16 * ((l >> 4) & 1) + 4 * p) * 2) + (keybase * 128 + 64 * dt);
    const s16x4 lo = __builtin_amdgcn_ds_read_tr16_b64_v4i16((LAS s16x4*)a), hi = __builtin_amdgcn_ds_read_tr16_b64_v4i16((LAS s16x4*)(a + 8 * 128));
    return __builtin_bit_cast(h8v, (__attribute__((ext_vector_type(8))) short){lo[0], lo[1], lo[2], lo[3], hi[0], hi[1], hi[2], hi[3]});
}
__device__ __forceinline__ void pv64(const f32x16 (&p)[2], const LAS unsigned char* VT, f32x16 (&o)[2], int l) {
#pragma unroll
    for (int kt = 0; kt < 2; ++kt)
#pragma unroll
        for (int s = 0; s < 2; ++s) { h8v pf;
#pragma unroll
            for (int j = 0; j < 8; ++j) pf[j] = (h16)p[kt][8 * s + j];
#pragma unroll
            for (int dt = 0; dt < 2; ++dt) { const h8v vf = vfrag(VT, 32 * kt + 16 * s, dt, l); o[dt] = __builtin_amdgcn_mfma_f32_32x32x16_f16(vf, pf, o[dt], 0, 0, 0); } }
}
struct AttSt { float mrun, lrun; f32x16 o[2]; };
__device__ __forceinline__ void att_reset(AttSt& S) { S.mrun = NEG; S.lrun = 0.f;
#pragma unroll
    for (int dt = 0; dt < 2; ++dt) S.o[dt] = (f32x16){0.f, 0.f, 0.f, 0.f, 0.f, 0.f, 0.f, 0.f, 0.f, 0.f, 0.f, 0.f, 0.f, 0.f, 0.f, 0.f}; }
template <class MaskF> __device__ __forceinline__ void sm_pv64(f32x16 (&st)[2], const LAS unsigned char* VT, AttSt& S, bool anymask, MaskF valid, int l) {
    float mx = NEG;
    if (anymask) {
#pragma unroll
        for (int kt = 0; kt < 2; ++kt)
#pragma unroll
            for (int reg = 0; reg < 16; ++reg) { const float v = valid(keyc(kt, reg)) ? st[kt][reg] : NEG; st[kt][reg] = v; mx = fmaxf(mx, v); }
    } else {
#pragma unroll
        for (int kt = 0; kt < 2; ++kt)
#pragma unroll
            for (int reg = 0; reg < 16; reg += 2) mx = fmaxf(mx, fmaxf(st[kt][reg], st[kt][reg + 1]));
    }
    mx = fmaxf(mx, xhalf(mx));
    const float mnew = fmaxf(S.mrun, mx), alpha = ex2(S.mrun - mnew); float ls = 0.f;
    if (anymask) {
#pragma unroll
        for (int kt = 0; kt < 2; ++kt)
#pragma unroll
            for (int reg = 0; reg < 16; ++reg) { const float v = st[kt][reg]; const float p = (v <= 0.5f * NEG) ? 0.f : ex2(v - mnew); st[kt][reg] = p; ls += p; }
    } else {
#pragma unroll
        for (int kt = 0; kt < 2; ++kt)
#pragma unroll
            for (int reg = 0; reg < 16; ++reg) { const float p = ex2(st[kt][reg] - mnew); st[kt][reg] = p; ls += p; }
    }
    S.lrun = S.lrun * alpha + ls; S.mrun = mnew;
    if (!__all(alpha == 1.f)) {
#pragma unroll
        for (int dt = 0; dt < 2; ++dt)
#pragma unroll
            for (int reg = 0; reg < 16; ++reg) S.o[dt][reg] *= alpha; }
    pv64(st, VT, S.o, l);
}
__device__ __forceinline__ void att_fold(f32x16 (&tot)[2], const AttSt& S, float gate) {
    const float lt = S.lrun + xhalf(S.lrun); const float sc = lt > 0.f ? gate / lt : 0.f;
#pragma unroll
    for (int dt = 0; dt < 2; ++dt)
#pragma unroll
        for (int reg = 0; reg < 16; ++reg) tot[dt][reg] += sc * S.o[dt][reg];
}
__device__ __forceinline__ void att_store(const f32x16 (&tot)[2], h16* dst  , int h) {
#pragma unroll
    for (int dt = 0; dt < 2; ++dt)
#pragma unroll
        for (int g4 = 0; g4 < 4; ++g4) { const int d0 = 32 * dt + 8 * g4 + 4 * h;
            *(u32x2*)(dst + d0) = pkh4((f32x4){tot[dt][4 * g4], tot[dt][4 * g4 + 1], tot[dt][4 * g4 + 2], tot[dt][4 * g4 + 3]}); }
}

constexpr int ATP_SCI = 4 * AT_BUF, ATP_SCL = ATP_SCI + 32768, ATP_TOT = ATP_SCL + 32768, ATP_MASK = ATP_TOT + 8192;
__device__ __forceinline__ void attn_prompt_unit(const Frame& F, const Args& args, int b, int kvh, int m) {
    const MW& w = args.w; int l = F.lane(); asm volatile("" : "+v"(l));
    const int r = l & 31, h = l >> 5, qsub = F.wave >> 2, gh = F.wave & 3, head = kvh * 4 + gh;
    const int qloc = 32 * qsub + r, qpos = 64 * m + qloc, qrow = b * LP + qpos;
    LAS unsigned char* L = F.lds;
    LAS float* SCI = (LAS float*)(L + ATP_SCI); LAS float* SCL = (LAS float*)(L + ATP_SCL); LAS float* TOT = (LAS float*)(L + ATP_TOT); LAS unsigned* MASK = (LAS unsigned*)(L + ATP_MASK);
    int tid = F.tid(); asm volatile("" : "+v"(tid));
    const int srow = tid >> 3, sc8 = tid & 7;
#pragma unroll
    for (int T = 0; T < 2; ++T) { const int i = 64 * T + srow; u32x4 kk = {0u, 0u, 0u, 0u}, vv = {0u, 0u, 0u, 0u};
        if (i < NC_P) { const size_t o = ((size_t)(b * NC_P + i) * 4 + kvh) * 64 + sc8 * 8; kk = *(const u32x4*)(w.KC16p + o); vv = *(const u32x4*)(w.VC16p + o); }
        *(LAS u32x4*)(L + T * AT_BUF + kaddr(srow, sc8)) = kk; *(LAS u32x4*)(L + T * AT_BUF + AT_KB + srow * 128 + sc8 * 16) = vv; }
    if (tid < 64) MASK[tid] = 0u;
    const float* gt = w.GATE + (size_t)qrow * 48;
    h8v qf[4];
#pragma unroll
    for (int ks = 0; ks < 4; ++ks) qf[ks] = *(const h8v*)(w.QP16 + (size_t)qrow * D + head * 64 + 16 * ks + 8 * h);
    __syncthreads();
    f32x16 tot[2];
    {
        f32x16 s0[2], s1[2]; qk64(L, qf, s0, r, h); qk64(L + AT_BUF, qf, s1, r, h);
        const int qc = qpos - 31 - 64 * h, c1lim = NC_P - 64 - 4 * h;
        float mx = NEG;
#pragma unroll
        for (int kt = 0; kt < 2; ++kt)
#pragma unroll
            for (int reg = 0; reg < 16; ++reg) { const int kc = keyc(kt, reg);
                const float v0 = (16 * kc <= qc) ? s0[kt][reg] : NEG, v1 = (kc < c1lim && 16 * kc + 1024 <= qc) ? s1[kt][reg] : NEG; s0[kt][reg] = v0; s1[kt][reg] = v1; mx = fmaxf(mx, fmaxf(v0, v1)); }
        mx = fmaxf(mx, xhalf(mx)); float sum = 0.f;
#pragma unroll
        for (int kt = 0; kt < 2; ++kt)
#pragma unroll
            for (int reg = 0; reg < 16; ++reg) { const float p0 = (s0[kt][reg] <= 0.5f * NEG) ? 0.f : ex2(s0[kt][reg] - mx), p1 = (s1[kt][reg] <= 0.5f * NEG) ? 0.f : ex2(s1[kt][reg] - mx); s0[kt][reg] = p0; s1[kt][reg] = p1; sum += p0 + p1; }
        sum += xhalf(sum); const float inv = sum > 0.f ? 1.f / sum : 0.f;
#pragma unroll
        for (int kt = 0; kt < 2; ++kt)
#pragma unroll
            for (int reg = 0; reg < 16; ++reg) { s0[kt][reg] *= inv; s1[kt][reg] *= inv; }
        { LAS float* sci = SCI + (gh * 32 + h) * 64 + qloc; LAS float* scl = SCL + (gh * 32 + h) * 64 + qloc;
#pragma unroll
        for (int kt = 0; kt < 2; ++kt)
#pragma unroll
            for (int g4 = 0; g4 < 4; ++g4) { constexpr int dummy = 0; (void)dummy; const int o0 = (8 * kt + 2 * g4) * 64, o1 = o0 + 16 * 64;
                sci[o0] = 2.f * (s0[kt][4 * g4] + s0[kt][4 * g4 + 1] + s0[kt][4 * g4 + 2]) + s0[kt][4 * g4 + 3]; scl[o0] = s0[kt][4 * g4 + 3];
                sci[o1] = 2.f * (s1[kt][4 * g4] + s1[kt][4 * g4 + 1] + s1[kt][4 * g4 + 2]) + s1[kt][4 * g4 + 3]; scl[o1] = s1[kt][4 * g4 + 3]; } }
        f32x16 oc[2];
#pragma unroll
        for (int dt = 0; dt < 2; ++dt) oc[dt] = (f32x16){0.f, 0.f, 0.f, 0.f, 0.f, 0.f, 0.f, 0.f, 0.f, 0.f, 0.f, 0.f, 0.f, 0.f, 0.f, 0.f};
        pv64(s0, L + AT_KB, oc, l); pv64(s1, L + AT_BUF + AT_KB, oc, l);
#pragma unroll
        for (int dt = 0; dt < 2; ++dt)
#pragma unroll
            for (int reg = 0; reg < 16; ++reg) tot[dt][reg] = gt[head] * oc[dt][reg];
    }
#pragma unroll
    for (int ks = 0; ks < 4; ++ks) qf[ks] = *(const h8v*)(w.QR16 + (size_t)qrow * D + head * 64 + 16 * ks + 8 * h);
    __syncthreads();
    {
        const int q = l, jg = F.wave; float me[4];
        const LAS float* sci = SCI + 4 * jg * 64 + q; const LAS float* scl = SCL + (4 * jg - 1) * 64 + q; LAS float* totw = TOT + 4 * jg * 64 + q;
#pragma unroll
        for (int e = 0; e < 4; ++e) { const int j = 4 * jg + e; float a = 0.f;
#pragma unroll
            for (int g = 0; g < 4; ++g) { a += sci[(g * 32 + e) * 64]; if (j > 0) a += scl[(g * 32 + e) * 64]; }
            const bool forced = (j == 0) || (j == m) || (j == m - 1);
            me[e] = forced ? INFINITY : (j <= m ? a : -INFINITY); totw[e * 64] = me[e]; }
        __syncthreads();
        unsigned bits = 0u;
        if (m < NSEL) {
#pragma unroll
            for (int e = 0; e < 4; ++e) if (4 * jg + e <= m) bits |= 1u << (4 * jg + e);
        } else {
            int rank[4] = {0, 0, 0, 0};
#pragma unroll 1
            for (int j2 = 0; j2 < 32; ++j2) { const float o = (TOT + q)[j2 * 64];
#pragma unroll
                for (int e = 0; e < 4; ++e) rank[e] += (o > me[e] || (o == me[e] && j2 < 4 * jg + e)) ? 1 : 0; }
#pragma unroll
            for (int e = 0; e < 4; ++e) if (rank[e] < NSEL) bits |= 1u << (4 * jg + e);
        }
        if (bits) atomicOr((unsigned*)(MASK + q), bits);
    }
    __syncthreads();
    const unsigned mq = MASK[qloc];
    const int n_sel = m + 1, w0 = m > 8 ? m - 8 : 0, n_all = n_sel + (m - w0 + 1);
    const h16* kvb = w.KV16 + (size_t)b * LP * 1024 + kvh * 64 + sc8 * 8;
    u32x4 kk0, vv0, kk1, vv1;
#define AT_LOAD1(t, K_, V_) do { if ((t) < n_all) { const int jb_ = (t) < n_sel ? (t) : w0 + (t) - n_sel; const h16* p_ = kvb + (size_t)(64 * jb_ + srow) * 1024 + ((t) < n_sel ? 0 : 512); K_ = *(const u32x4*)p_; V_ = *(const u32x4*)(p_ + 256); } } while (0)
#define AT_LOAD(p) do { AT_LOAD1(2 * (p), kk0, vv0); AT_LOAD1(2 * (p) + 1, kk1, vv1); } while (0)
#define AT_PUT(buf) do { int bo_ = (buf) * 2 * AT_BUF; asm volatile("" : "+v"(bo_)); LAS unsigned char* q_ = L + bo_; \
        *(LAS u32x4*)(q_ + kaddr(srow, sc8)) = kk0; *(LAS u32x4*)(q_ + AT_KB + srow * 128 + sc8 * 16) = vv0; \
        *(LAS u32x4*)(q_ + AT_BUF + kaddr(srow, sc8)) = kk1; *(LAS u32x4*)(q_ + AT_BUF + AT_KB + srow * 128 + sc8 * 16) = vv1; } while (0)
    const int np = (n_all + 1) >> 1;
    AT_LOAD(0); AT_PUT(0);
    if (np > 1) AT_LOAD(1);
    __syncthreads();
    AttSt S; att_reset(S);
    const int qd = qloc - 4 * h;
    for (int pp = 0; pp < np; ++pp) {
        if (pp + 1 < np) AT_PUT((pp + 1) & 1);
        if (pp + 2 < np) AT_LOAD(pp + 2);
#pragma unroll
        for (int u2 = 0; u2 < 2; ++u2) {
            const int t = 2 * pp + u2;
            if (t < n_all) {
                int bo = ((pp & 1) * 2 + u2) * AT_BUF; asm volatile("" : "+v"(bo));
                const LAS unsigned char* KT = L + bo;
                if (t == n_sel) { att_fold(tot, S, gt[16 + head]); att_reset(S); }
                if (t < n_sel) {
                    const int jb = t; const bool selq = (mq >> jb) & 1u;
                    if (__any(selq)) { f32x16 st[2]; qk64(KT, qf, st, r, h); const bool diag = jb == m;
                        sm_pv64(st, KT + AT_KB, S, diag || !__all(selq), [&](int kc) { return selq && (!diag || kc <= qd); }, l); }
                } else {
                    const int jb = w0 + t - n_sel; f32x16 st[2]; qk64(KT, qf, st, r, h); const bool diag = jb == m, far = jb == m - 8;
                    sm_pv64(st, KT + AT_KB, S, diag || far, [&](int kc) { return diag ? kc <= qd : (far ? kc > qd : true); }, l);
                }
            }
        }
        __syncthreads();
    }
#undef AT_LOAD1
    att_fold(tot, S, gt[32 + head]);
#undef AT_LOAD
#undef AT_PUT
    att_store(tot, w.G16 + (size_t)qrow * D + head * 64, h);
}

constexpr int ATS_SM = 8 * AT_BUF;
__device__ __forceinline__ void wave_load_f32(LAS unsigned char* WK, LAS unsigned char* WV, const float* base  , unsigned stride, int l) {
    const unsigned c16 = l & 15, kq = l >> 4; const unsigned lo = kq * stride + 4u * c16;
    LAS unsigned char* wk = WK + kq * AT_KST + (c16 >> 1) * 16 + (c16 & 1) * 8; LAS unsigned char* wv = WV + kq * 128 + c16 * 8;
#pragma unroll
    for (int half = 0; half < 2; ++half) { f32x4 v[16];
#pragma unroll
        for (int i = 0; i < 16; ++i) v[i] = *(const f32x4*)(base + (lo + (unsigned)(4 * i) * stride + (unsigned)half * 256u));
#pragma unroll
        for (int i = 0; i < 16; ++i) { const u32x2 pk = pkh4(v[i]);
            if (half == 0) *(LAS u32x2*)(wk + 4 * i * AT_KST) = pk; else *(LAS u32x2*)(wv + 4 * i * 128) = pk; } }
}
__device__ __forceinline__ void wave_load_new(LAS unsigned char* WK, LAS unsigned char* WV, const h16* kv16rows  , int kslot, int l) {
    const u32x4 z = {0u, 0u, 0u, 0u};
#pragma unroll
    for (int it = 0; it < 8; ++it) { *(LAS u32x4*)(WK + (it * 64 + l) * 16) = z; *(LAS u32x4*)(WV + (it * 64 + l) * 16) = z; }
    const int row = l >> 3, c = l & 7; const h16* p = kv16rows + (size_t)row * 1024 + kslot * 256 + c * 8;
    const u32x4 kk = *(const u32x4*)p, vv = *(const u32x4*)(p + 256);
    *(LAS u32x4*)(WK + kaddr(row, c)) = kk; *(LAS u32x4*)(WV + row * 128 + c * 16) = vv;
}
__device__ __forceinline__ void attn_sample_unit(const Frame& F, const Args& args, int b, int kvh) {
    const MW& w = args.w; int l = F.lane(); asm volatile("" : "+v"(l));
    const int r = l & 31, h = l >> 5, W = F.wave, t = r >> 2, gh = r & 3, head = kvh * 4 + gh;
    const int qrow = RP + b * LS + t, qpos = PAST + t;
    LAS unsigned char* L = F.lds; LAS unsigned char* WK = L + W * AT_BUF; LAS unsigned char* WV = WK + AT_KB;
    LAS float* WMX = (LAS float*)(L + ATS_SM); LAS float* WSM = WMX + 256; LAS float* WMX2 = WMX + 512; LAS float* WSM2 = WMX + 768; LAS float* WMX3 = WMX + 1024; LAS float* WSM3 = WMX + 1280;
    LAS unsigned* SELW = (LAS unsigned*)(L + ATS_SM + 6144); LAS float* TOTw = (LAS float*)(WK + 4096);
    const float* cache = (const float*)args.in[2]; const float* cwin = (const float*)args.in[3]; const int* ptab = (const int*)args.in[7];
    const float* gt = w.GATE + (size_t)qrow * 48;
#pragma unroll
    for (int it = 0; it < 8; ++it) { const int id = it * 64 + l, row = id >> 3, c = id & 7, i = 64 * W + row; u32x4 kk = {0u, 0u, 0u, 0u}, vv = {0u, 0u, 0u, 0u};
        if (i < NC_S) { const size_t o = ((size_t)(b * NC_S + i) * 4 + kvh) * 64 + c * 8; kk = *(const u32x4*)(w.KC16s + o); vv = *(const u32x4*)(w.VC16s + o); }
        *(LAS u32x4*)(WK + kaddr(row, c)) = kk; *(LAS u32x4*)(WV + row * 128 + c * 16) = vv; }
    h8v qf[4];
#pragma unroll
    for (int ks = 0; ks < 4; ++ks) qf[ks] = *(const h8v*)(w.QP16 + (size_t)qrow * D + head * 64 + 16 * ks + 8 * h);
    f32x16 tot[2];
    {
        f32x16 st[2]; qk64(WK, qf, st, r, h);
        const int clim = NC_S - 64 * W - 4 * h, qc = qpos - 31 - 1024 * W - 64 * h;
        float mx = NEG;
#pragma unroll
        for (int kt = 0; kt < 2; ++kt)
#pragma unroll
            for (int reg = 0; reg < 16; ++reg) { const int kc = keyc(kt, reg); const float v = (kc < clim && 16 * kc <= qc) ? st[kt][reg] : NEG; st[kt][reg] = v; mx = fmaxf(mx, v); }
        mx = fmaxf(mx, xhalf(mx));
        if (h == 0) WMX[W * 32 + r] = mx;
        __syncthreads();
        float gm = NEG;
#pragma unroll
        for (int ww = 0; ww < 8; ++ww) gm = fmaxf(gm, WMX[ww * 32 + r]);
        float sum = 0.f;
#pragma unroll
        for (int kt = 0; kt < 2; ++kt)
#pragma unroll
            for (int reg = 0; reg < 16; ++reg) { const float p = (st[kt][reg] <= 0.5f * NEG) ? 0.f : ex2(st[kt][reg] - gm); st[kt][reg] = p; sum += p; }
        sum += xhalf(sum);
        if (h == 0) WSM[W * 32 + r] = sum;
        __syncthreads();
        float ts = 0.f;
#pragma unroll
        for (int ww = 0; ww < 8; ++ww) ts += WSM[ww * 32 + r];
        const float inv = ts > 0.f ? 1.f / ts : 0.f;
#pragma unroll
        for (int kt = 0; kt < 2; ++kt)
#pragma unroll
            for (int reg = 0; reg < 16; ++reg) st[kt][reg] *= inv;
        LAS float* SCw = (LAS float*)WK;
#pragma unroll
        for (int kt = 0; kt < 2; ++kt)
#pragma unroll
            for (int g4 = 0; g4 < 4; ++g4) { const int ml = 8 * kt + 2 * g4 + h;
                SCw[ml * 32 + r] = 2.f * (st[kt][4 * g4] + st[kt][4 * g4 + 1] + st[kt][4 * g4 + 2]) + st[kt][4 * g4 + 3]; SCw[512 + ml * 32 + r] = st[kt][4 * g4 + 3]; }
        f32x16 oc[2];
#pragma unroll
        for (int dt = 0; dt < 2; ++dt) oc[dt] = (f32x16){0.f, 0.f, 0.f, 0.f, 0.f, 0.f, 0.f, 0.f, 0.f, 0.f, 0.f, 0.f, 0.f, 0.f, 0.f, 0.f};
        pv64(st, WV, oc, l);
#pragma unroll
        for (int dt = 0; dt < 2; ++dt)
#pragma unroll
            for (int reg = 0; reg < 16; ++reg) tot[dt][reg] = gt[head] * oc[dt][reg];
    }
    __syncthreads();
    {
        float me[3];
#pragma unroll
        for (int e = 0; e < 3; ++e) { const int j = e < 2 ? l + 64 * e : 128; float a = 0.f;
            if (e < 2 || l == 0) {
#pragma unroll
                for (int g = 0; g < 4; ++g) { const int col = 4 * W + g;
                    if (j < 128) a += ((const LAS float*)(L + (j >> 4) * AT_BUF))[(j & 15) * 32 + col];
                    if (j > 0) a += ((const LAS float*)(L + ((j - 1) >> 4) * AT_BUF))[512 + ((j - 1) & 15) * 32 + col]; }
                const bool forced = (j == 0) || (j == 128) || (j == 127);
                me[e] = forced ? INFINITY : a; TOTw[j] = me[e];
            } else me[e] = -INFINITY; }
        asm volatile("s_waitcnt lgkmcnt(0)" ::: "memory");
        int rank[3] = {0, 0, 0};
#pragma unroll 1
        for (int j2 = 0; j2 < NS_S; ++j2) { const float o = TOTw[j2];
#pragma unroll
            for (int e = 0; e < 3; ++e) { const int j = e < 2 ? l + 64 * e : 128; rank[e] += (o > me[e] || (o == me[e] && j2 < j)) ? 1 : 0; } }
        const unsigned long long b0 = __ballot(rank[0] < NSEL), b1 = __ballot(rank[1] < NSEL), b2 = __ballot(l == 0 && rank[2] < NSEL);
        if (l == 0) { SELW[W * 8 + 0] = (unsigned)b0; SELW[W * 8 + 1] = (unsigned)(b0 >> 32); SELW[W * 8 + 2] = (unsigned)b1; SELW[W * 8 + 3] = (unsigned)(b1 >> 32); SELW[W * 8 + 4] = (unsigned)(b2 & 1ull); }
    }
    __syncthreads();
    const h16* qrp = w.QR16 + (size_t)qrow * D + head * 64 + 8 * h;
#define ATS_LOADQ() do { asm volatile("" ::: "memory"); _Pragma("unroll") for (int ks = 0; ks < 4; ++ks) qf[ks] = *(const h8v*)(qrp + 16 * ks); } while (0)
    const h16* newrows = w.KV16 + (size_t)(RP + b * LS) * 1024 + kvh * 64;
    AttSt S; att_reset(S);
    const int td = t - 4 * h, tw = t - 64 * W - 4 * h;
    for (int jb = W; jb < NS_S; jb += 8) {
        unsigned uw = 0u;
#pragma unroll
        for (int tt = 0; tt < 8; ++tt) uw |= SELW[tt * 8 + (jb >> 5)];
        if (!((uw >> (jb & 31)) & 1u)) continue;
        if (jb < 128) { const int page = __builtin_amdgcn_readfirstlane(ptab[b * NPAGES + (jb >> 1)]);
            const float* base = cache + (((size_t)page * PAGE + (jb & 1) * 64) * 4 + 2) * 256 + kvh * 64;
            wave_load_f32(WK, WV, base, 1024u, l); }
        else wave_load_new(WK, WV, newrows, 0, l);
        const unsigned sw = SELW[t * 8 + (jb >> 5)];
        const bool selq = (sw >> (jb & 31)) & 1u; const bool isnew = jb == 128;
        ATS_LOADQ(); f32x16 st[2]; qk64(WK, qf, st, r, h);
        sm_pv64(st, WV, S, true, [&](int kc) { return selq && (!isnew || kc <= td); }, l);
    }
    { const float lt = S.lrun + xhalf(S.lrun); if (h == 0) { WMX2[W * 32 + r] = S.mrun; WSM2[W * 32 + r] = lt; } }
    __syncthreads();
    { float gm = NEG;
#pragma unroll
      for (int ww = 0; ww < 8; ++ww) gm = fmaxf(gm, WMX2[ww * 32 + r]);
      float gl = 0.f;
#pragma unroll
      for (int ww = 0; ww < 8; ++ww) gl += WSM2[ww * 32 + r] * ex2(WMX2[ww * 32 + r] - gm);
      const float f = gl > 0.f ? gt[16 + head] * ex2(S.mrun - gm) / gl : 0.f;
#pragma unroll
      for (int dt = 0; dt < 2; ++dt)
#pragma unroll
          for (int reg = 0; reg < 16; ++reg) tot[dt][reg] += f * S.o[dt][reg]; }
    att_reset(S);
    { const float* base = cwin + ((size_t)(b * WIN + 64 * W) * 2) * 256 + kvh * 64;
      wave_load_f32(WK, WV, base, 512u, l);
      ATS_LOADQ(); f32x16 st[2]; qk64(WK, qf, st, r, h);
      sm_pv64(st, WV, S, W == 0, [&](int kc) { return kc > tw; }, l); }
    if (W == 0) { wave_load_new(WK, WV, newrows, 2, l); ATS_LOADQ(); f32x16 st[2]; qk64(WK, qf, st, r, h); sm_pv64(st, WV, S, true, [&](int kc) { return kc <= td; }, l); }
    { const float lt = S.lrun + xhalf(S.lrun); if (h == 0) { WMX3[W * 32 + r] = S.mrun; WSM3[W * 32 + r] = lt; } }
    __syncthreads();
    { float gm = NEG;
#pragma unroll
      for (int ww = 0; ww < 8; ++ww) gm = fmaxf(gm, WMX3[ww * 32 + r]);
      float gl = 0.f;
#pragma unroll
      for (int ww = 0; ww < 8; ++ww) gl += WSM3[ww * 32 + r] * ex2(WMX3[ww * 32 + r] - gm);
      const float f = gl > 0.f ? gt[32 + head] * ex2(S.mrun - gm) / gl : 0.f;
#pragma unroll
      for (int dt = 0; dt < 2; ++dt)
#pragma unroll
          for (int reg = 0; reg < 16; ++reg) tot[dt][reg] += f * S.o[dt][reg]; }
    { LAS float* PART = (LAS float*)WK + 4 * h * 32 + r;
#pragma unroll
      for (int dt = 0; dt < 2; ++dt)
#pragma unroll
          for (int reg = 0; reg < 16; ++reg) PART[(32 * dt + (reg & 3) + 8 * (reg >> 2)) * 32] = tot[dt][reg]; }
    __syncthreads();
    { int tid = F.tid(); asm volatile("" : "+v"(tid)); const int col = tid >> 4, d0 = (tid & 15) * 4; f32x4 a = {0.f, 0.f, 0.f, 0.f};
#pragma unroll
      for (int ww = 0; ww < 8; ++ww) { const LAS float* P = (const LAS float*)(L + ww * AT_BUF);
#pragma unroll
          for (int e = 0; e < 4; ++e) a[e] += P[(d0 + e) * 32 + col]; }
      *(u32x2*)(w.G16 + (size_t)(RP + b * LS + (col >> 2)) * D + (kvh * 4 + (col & 3)) * 64 + d0) = pkh4(a); }
    __syncthreads();
}

#undef ATS_LOADQ
constexpr int CW_ATTQ = 512;
__device__ __forceinline__ void attn_phase(const Frame& F, const Args& args, int pass) {
    volatile LAS int* slot = (volatile LAS int*)(F.lds + LDS_MISC + 64);
    constexpr int NU = BS * KVH + BP * KVH * 32;
    for (;;) {
        if (F.tid() == 0) slot[0] = (int)__hip_atomic_fetch_add(args.w.ctl + CW_ATTQ + 64 * pass, 1u, __ATOMIC_RELAXED, __HIP_MEMORY_SCOPE_AGENT);
        __syncthreads();
        const int u = slot[0];
        __syncthreads();
        if (u >= NU) break;
        if (u < BS * KVH) attn_sample_unit(F, args, u >> 2, u & 3);
        else { const int v = u - BS * KVH; attn_prompt_unit(F, args, (v & 31) >> 2, v & 3, 31 - (v >> 5)); }
    }
}
constexpr int NPHASE = 19;
constexpr int CW_BAR = 1024;
__global__ void __launch_bounds__(NT, 2) mega(Args args) {
    extern __shared__ __attribute__((aligned(16))) unsigned char lds_raw[];
    Frame F; F.lds = (LAS unsigned char*)lds_raw; F.wave = __builtin_amdgcn_readfirstlane(threadIdx.x >> 6); F.G = gridDim.x; F.bid = blockIdx.x;
    const MW& w = args.w;
    volatile LAS unsigned* MISC = (volatile LAS unsigned*)(F.lds + LDS_MISC);
    if (F.tid() < 64) MISC[F.tid()] = 0u;
    __syncthreads();
    const int lo = args.ph_lo, hi = args.ph_hi;
    XcdBarrier bar; bar.bar = w.ctl + CW_BAR; bar.x = 0; bar.st = nullptr;
    if (hi - lo > 1) bar = xcd_barrier_post(w.ctl + CW_BAR, MISC + 8, F.wave);
    constexpr int pass = 0;
#ifndef PHASE_MASK
#define PHASE_MASK 0xFFFFFFFFu
#endif
#define IN(k) (((PHASE_MASK >> (k)) & 1u) && lo <= (k) && (k) < hi)
#define SEAM(k) do { if (IN(k) && IN((k) + 1)) xcd_barrier(bar, F.wave); } while (0)
    float* X = w.out + O_Y;
    const float* MOD = w.MOD;

    if (IN(0)) { p0_prep(F, args); } SEAM(0);
    if (IN(1)) { RowPass P{}; P.xa = INP(0); P.xb = INP(1); P.w1 = INP(10); P.sh1 = 0; P.H1 = w.H16; row_pass<F_H1, 0>(F, MOD, P); } SEAM(1);
    if (IN(2)) { s5_phase(F, args); } SEAM(2);
    if (IN(3)) { { pg8::StaticOrder S; S.init(RP, D, F.G, F.bid); pg8::PlainLay L{w.G16, w.Wglu, D}; EpiGlu E{w.G16, INP(23), w.OUTH}; pg8::gemm_phase(F.lds, F.wave, D, S, L, E); }
                 { int wv2 = F.wave; asm volatile("" : "+s"(wv2)); pg8::SplitOrder S{F.G, F.bid, 16}; pg8::SplitLay L{w.G16 + (size_t)RP * D, w.Wglu, D}; EpiPart E{w.PART}; pg8::gemm_phase(F.lds, wv2, 256, S, L, E); } } SEAM(3);
    if (IN(4)) { RowPass P{}; P.xa = INP(0); P.xb = INP(1); P.O = w.OUTH; P.part = w.PART; P.nsplit = 4; P.glu_g = w.G16; P.glu_b = INP(23); P.wpost = INP(11); P.gate_off = 2048; P.XHout = w.XH; P.w1 = INP(10) + D; P.sh1 = 3072; P.H1 = w.H16; row_pass<F_O | F_PART | F_GLU | F_XHOUT | F_H1, 4>(F, MOD, P); } SEAM(4);
    if (IN(5)) { pg8::StaticOrder S; S.init(R, F2, F.G, F.bid); pg8::PlainLay L{w.H16, w.Wup0, D}; EpiUp E{w.UP16, w.out + O_CONV_P, w.out + O_CONV_S}; pg8::gemm_phase(F.lds, F.wave, D, S, L, E); } SEAM(5);
    if (IN(6)) { conv_phase(F, args, 0); } SEAM(6);
    if (IN(7)) { { pg8::StaticOrder S; S.init(RP, D, F.G, F.bid); pg8::PlainLay L{w.ACT16, w.Wdn0, FF}; EpiH16 E{w.OUTH, D}; pg8::gemm_phase(F.lds, F.wave, FF, S, L, E); }
                 { int wv2 = F.wave; asm volatile("" : "+s"(wv2)); pg8::SplitOrder S{F.G, F.bid, 44}; pg8::SplitLay L{w.ACT16 + (size_t)RP * FF, w.Wdn0, FF}; EpiPart E{w.PART}; pg8::gemm_phase(F.lds, wv2, 256, S, L, E); } } SEAM(7);
    if (IN(8)) { RowPass P{}; P.xh = w.XH; P.XHout = w.XH; P.O = w.OUTH; P.part = w.PART; P.nsplit = 11; P.wpost = INP(11) + D; P.gate_off = 3072 + 2048;
                 P.w1 = INP(28); P.sh1 = 12288; P.H1 = w.HKV16; P.w2 = INP(10) + 2 * D; P.sh2 = 6144; P.H2 = w.H16; row_pass<F_XH | F_XHOUT | F_O | F_PART | F_H1 | F_H2, 11>(F, MOD, P); } SEAM(8);
    if (IN(9)) { KvQgOrder S; S.init(F.G, F.bid); KvQgLay L{w.HKV16, w.Wkv, w.H16, w.Wqg}; EpiKvQg E{w.ROPE, w.KV16, w.CMPP, w.out, w.QP16, w.QR16, w.GATE}; pg8::gemm_phase(F.lds, F.wave, D, S, L, E); } SEAM(9);
    if (IN(10)) { { CmpOrderS S{F.G, F.bid}; CmpLayS L{w.CMP16, w.Wc1k, w.Wc1v}; EpiCmpS E{w.PBs16}; pg8::gemm_phase(F.lds, F.wave, 1024, S, L, E); }
                  { int wv2 = F.wave; asm volatile("" : "+s"(wv2)); CmpOrderP S{F.G, F.bid}; CmpLayP L{w.CMPP, w.Wc1k, w.Wc1v}; EpiCmpP E{w.PBp}; pg8::gemm_phase(F.lds, wv2, 256, S, L, E); } } SEAM(10);
    if (IN(11)) { cmp2_phase(F, args); } SEAM(11);
    if (IN(12)) { attn_phase(F, args, pass); } SEAM(12);
    if (IN(13)) { { pg8::StaticOrder S; S.init(RP, D, F.G, F.bid); pg8::PlainLay L{w.G16, w.Wo, D}; EpiH16 E{w.OUTH, D}; pg8::gemm_phase(F.lds, F.wave, D, S, L, E); }
                  { int wv2 = F.wave; asm volatile("" : "+s"(wv2)); pg8::SplitOrder S{F.G, F.bid, 16}; pg8::SplitLay L{w.G16 + (size_t)RP * D, w.Wo, D}; EpiPart E{w.PART}; pg8::gemm_phase(F.lds, wv2, 256, S, L, E); } } SEAM(13);
    if (IN(14)) { RowPass P{}; P.xh = w.XH; P.XHout = w.XH; P.O = w.OUTH; P.part = w.PART; P.nsplit = 4; P.wpost = INP(11) + 2 * D; P.gate_off = 6144 + 2048; P.w1 = INP(10) + 3 * D; P.sh1 = 9216; P.H1 = w.H16; row_pass<F_XH | F_XHOUT | F_O | F_PART | F_H1, 4>(F, MOD, P); } SEAM(14);
    if (IN(15)) { pg8::StaticOrder S; S.init(R, F2, F.G, F.bid); pg8::PlainLay L{w.H16, w.Wup1, D}; EpiUp E{w.UP16, w.out + O_CONV_P + (size_t)BP * 2 * F2, w.out + O_CONV_S + (size_t)BS * 2 * F2}; pg8::gemm_phase(F.lds, F.wave, D, S, L, E); } SEAM(15);
    if (IN(16)) { conv_phase(F, args, 1); } SEAM(16);
    if (IN(17)) { { pg8::StaticOrder S; S.init(RP, D, F.G, F.bid); pg8::PlainLay L{w.ACT16, w.Wdn1, FF}; EpiH16 E{w.OUTH, D}; pg8::gemm_phase(F.lds, F.wave, FF, S, L, E); }
                  { int wv2 = F.wave; asm volatile("" : "+s"(wv2)); pg8::SplitOrder S{F.G, F.bid, 44}; pg8::SplitLay L{w.ACT16 + (size_t)RP * FF, w.Wdn1, FF}; EpiPart E{w.PART}; pg8::gemm_phase(F.lds, wv2, 256, S, L, E); } } SEAM(17);
    if (IN(18)) { RowPass P{}; P.xh = w.XH; P.O = w.OUTH; P.part = w.PART; P.nsplit = 11; P.wpost = INP(11) + 3 * D; P.gate_off = 9216 + 2048; P.Xout = X; row_pass<F_XH | F_O | F_PART | F_XOUT, 11>(F, MOD, P); }


#undef IN
#undef SEAM
}
#undef INP
}
extern "C" void kernel_launch(void* const* d_in, const int* in_sizes, int n_in, void* d_out, int out_size, void* d_ws, size_t ws_size, hipStream_t stream) {
    using namespace cfg;
    if (n_in != 38 || out_size != (int)O_END) { fprintf(stderr, "kernel_launch: unexpected problem shape (n_in %d, out %d)\n", n_in, out_size); return; }
    char* ws = (char*)d_ws; size_t off = 0;
    auto carve = [&](size_t bytes) { char* p = ws + off; off += (bytes + 255) & ~(size_t)255; return p; };
    mk::Args a{};
    for (int i = 0; i < 38; ++i) a.in[i] = d_in[i];
    mk::MW& w = a.w;
    w.ctl = (unsigned*)carve(1 << 20);
    w.MOD = (float*)carve((size_t)NSEQ * MODW * 4); w.ROPE = (float2*)carve((size_t)NROPE * 32 * 8); w.CB = (float*)carve(256 * 4);
    w.Wglu = (mk::h16*)carve((size_t)D * D * 2); w.Wup0 = (mk::h16*)carve((size_t)F2 * D * 2); w.Wup1 = (mk::h16*)carve((size_t)F2 * D * 2);
    w.Wdn0 = (mk::h16*)carve((size_t)D * FF * 2); w.Wdn1 = (mk::h16*)carve((size_t)D * FF * 2); w.Wkv = (mk::h16*)carve((size_t)NKV * D * 2);
    w.Wqg = (mk::h16*)carve((size_t)1280 * D * 2); w.Wo = (mk::h16*)carve((size_t)D * D * 2); w.Wc1k = (mk::h16*)carve((size_t)256 * 1024 * 2); w.Wc1v = (mk::h16*)carve((size_t)256 * 1024 * 2);
    w.H16 = (mk::h16*)carve((size_t)(R + 64) * D * 2); w.G16 = (mk::h16*)carve((size_t)R * D * 2); w.UP16 = (mk::h16*)carve((size_t)R * F2 * 2); w.ACT16 = (mk::h16*)carve((size_t)R * FF * 2);
    w.HKV16 = (mk::h16*)carve((size_t)R * D * 2); w.KV16 = (mk::h16*)carve((size_t)R * 1024 * 2); w.CMPP = (mk::h16*)carve((size_t)RP * 512 * 2); w.QP16 = (mk::h16*)carve((size_t)R * D * 2); w.QR16 = (mk::h16*)carve((size_t)R * D * 2);
    w.CMP16 = (mk::h16*)carve((size_t)BS * PAST * 512 * 2);
    w.KC16p = (mk::h16*)carve((size_t)BP * 128 * 256 * 2); w.VC16p = (mk::h16*)carve((size_t)BP * 128 * 256 * 2); w.KC16s = (mk::h16*)carve((size_t)BS * 512 * 256 * 2); w.VC16s = (mk::h16*)carve((size_t)BS * 512 * 256 * 2);
    w.OUTF = (float*)carve(256); w.OUTH = (mk::h16*)carve((size_t)R * D * 2); w.GATE = (float*)carve((size_t)R * 48 * 4); w.PBp = (float*)carve((size_t)4 * 2 * 4096 * 256 * 4); w.PBs = (float*)carve(256); w.XH = (mk::h16*)carve((size_t)R * D * 2); w.PBs16 = (mk::h16*)carve((size_t)2 * 65536 * 256 * 2); w.PART = (float*)carve((size_t)11 * 256 * 1024 * 4);
    w.out = (float*)d_out;
    if (off > ws_size) { fprintf(stderr, "kernel_launch: workspace too small (%zu > %zu)\n", off, ws_size); return; }
    static int grid = 0;
    if (!grid) {
        int dev = 0, cus = 0, per_cu = 0;
        if (hipGetDevice(&dev) != hipSuccess || hipDeviceGetAttribute(&cus, hipDeviceAttributeMultiprocessorCount, dev) != hipSuccess) cus = 256;
        if (hipFuncSetAttribute((const void*)mk::mega, hipFuncAttributeMaxDynamicSharedMemorySize, mk::LDS_BYTES) != hipSuccess) fprintf(stderr, "kernel_launch: hipFuncSetAttribute failed\n");
        if (hipOccupancyMaxActiveBlocksPerMultiprocessor(&per_cu, (const void*)mk::mega, mk::NT, mk::LDS_BYTES) != hipSuccess || per_cu < 1)
            fprintf(stderr, "kernel_launch: occupancy query reports %d workgroups per CU\n", per_cu);
        (void)hipGetLastError();
        grid = cus > 0 ? cus : 256;
    }
    if (hipMemsetAsync(w.ctl, 0, 1 << 20, stream) != hipSuccess) { fprintf(stderr, "kernel_launch: memset failed\n"); return; }
    a.ph_lo = 0; a.ph_hi = mk::NPHASE;
    hipLaunchKernelGGL(mk::mega, dim3(grid), dim3(mk::NT), mk::LDS_BYTES, stream, a);
}
```

```cpp
#include <hip/hip_runtime.h>
#include <stdint.h>
#include <stdio.h>
#include <math.h>

namespace cfg {
constexpr int D = 1024, BP = 8, LP = 2048, BS = 32, LS = 8, RP = BP * LP, RS = BS * LS, R = RP + RS, NSEQ = BP + BS;
constexpr int PAST = 8192, PAGE = 128, NPAGES = 64;
constexpr int G = 64, P = 64;
constexpr int NH = 16, HD = 64, KVH = 4;
constexpr int FF = 2816, F2 = 5632;
constexpr int NQG = 1072, NKV = 1536;
constexpr int WIN = 512;
constexpr int NC_P = 127, NC_S = 511, NS_P = 32, NS_S = 129, NSEL = 16;
constexpr int MODW = 4 * 3072 + 2048;
constexpr int NROPE = LP + LS;
constexpr float EPS = 1e-6f, NEG = -1e30f;
constexpr size_t O_Y = 0, O_ROWS = (size_t)R * 1024, O_WIN_P = O_ROWS + (size_t)R * 1024, O_WIN_S = O_WIN_P + (size_t)BP * WIN * 512,
                 O_SRE_P = O_WIN_S + (size_t)RS * 512, O_SIM_P = O_SRE_P + BP * G * P, O_SRE_S = O_SIM_P + BP * G * P, O_SIM_S = O_SRE_S + BS * G * P,
                 O_CONV_P = O_SIM_S + BS * G * P, O_CONV_S = O_CONV_P + (size_t)2 * BP * 2 * F2, O_END = O_CONV_S + (size_t)2 * BS * 2 * F2;
static_assert(O_END == 37535744, "output size");
__host__ __device__ __forceinline__ int modrow(int row) { return row < RP ? (row >> 11) : BP + ((row - RP) >> 3); }
__host__ __device__ __forceinline__ int ropeidx(int row) { return row < RP ? (row & (LP - 1)) : LP + ((row - RP) & 7); }
}
namespace mk {
using namespace cfg;
#define LAS __attribute__((address_space(3)))
#define GAS __attribute__((address_space(1)))
typedef _Float16 h16;
typedef _Float16 h2v __attribute__((ext_vector_type(2)));
typedef _Float16 h4v __attribute__((ext_vector_type(4)));
typedef _Float16 h8v __attribute__((ext_vector_type(8)));
typedef float f32x2 __attribute__((ext_vector_type(2)));
typedef float f32x4 __attribute__((ext_vector_type(4)));
typedef float f32x16 __attribute__((ext_vector_type(16)));
typedef unsigned u32x2 __attribute__((ext_vector_type(2)));
typedef unsigned u32x4 __attribute__((ext_vector_type(4)));
typedef short s16x4 __attribute__((ext_vector_type(4)));
constexpr int NT = 512, NW = 8;
constexpr int LDS_BYTES = 147456;
constexpr int LDS_MISC = LDS_BYTES - 256;

__device__ __forceinline__ int lane_id() { int l; asm volatile("v_mbcnt_lo_u32_b32 %0, -1, 0\n\tv_mbcnt_hi_u32_b32 %0, -1, %0" : "=v"(l)); return l; }
__device__ __forceinline__ float wsum(float v) {
#pragma unroll
    for (int o = 32; o >= 1; o >>= 1) v += __shfl_xor(v, o);
    return v;
}
__device__ __forceinline__ float wmaxf(float v) {
#pragma unroll
    for (int o = 32; o >= 1; o >>= 1) v = fmaxf(v, __shfl_xor(v, o));
    return v;
}
__device__ __forceinline__ float fexp(float x) { return __builtin_amdgcn_exp2f(x * 1.4426950408889634f); }
__device__ __forceinline__ float sigm(float x) { return __builtin_amdgcn_rcpf(1.f + fexp(-x)); }
__device__ __forceinline__ float silu(float x) { return x * sigm(x); }
__device__ __forceinline__ float gelu_t(float x) { const float u = 0.7978845608028654f * (x + 0.044715f * x * x * x); return x * sigm(2.f * u); }
__device__ __forceinline__ unsigned pkh(float a, float b) { h2v v; v.x = (h16)a; v.y = (h16)b; return __builtin_bit_cast(unsigned, v); }
__device__ __forceinline__ u32x2 pkh4(f32x4 v) { u32x2 r; r.x = pkh(v[0], v[1]); r.y = pkh(v[2], v[3]); return r; }

#define XB_TMO      128
#define XB_XCNT(j)  (256  + 64 * (j))
#define XB_XSUB(j)  (1280 + 64 * (j))
#define XB_XGEN(j)  (2304 + 64 * (j))
#define XB_TOP      3328
#define XB_TOPGEN   3392
#define XCD_BAR_WORDS 3456
#define XB_SPIN_CAP (1u << 18)
__device__ __forceinline__ unsigned xb_ld(unsigned* p)              { return __hip_atomic_load(p, __ATOMIC_RELAXED, __HIP_MEMORY_SCOPE_AGENT); }
__device__ __forceinline__ unsigned xb_add(unsigned* p, unsigned v) { return __hip_atomic_fetch_add(p, v, __ATOMIC_RELAXED, __HIP_MEMORY_SCOPE_AGENT); }
__device__ __forceinline__ unsigned xb_xcc_id() { return (unsigned)__builtin_amdgcn_s_getreg((3 << 11) | 20) & 0xFu; }
#define XB_SPIN(cond, bar) do { unsigned _sp = 0; while (cond) { __builtin_amdgcn_s_sleep(1); \
    if ((++_sp & 255u) == 0u) { if (xb_ld(&(bar)[XB_TMO])) break; if (_sp > XB_SPIN_CAP) { atomicAdd(&(bar)[XB_TMO], 1u); break; } } } } while (0)
struct XcdBarrier { unsigned* bar; unsigned x; volatile LAS unsigned* st; };
__device__ __forceinline__ XcdBarrier xcd_barrier_post(unsigned* bar, volatile LAS unsigned* st, int wave) {
    XcdBarrier b; b.bar = bar; b.x = xb_xcc_id(); b.st = st;
    if (wave == 0 && lane_id() == 0) (void)xb_add(&bar[XB_XCNT(b.x)], 1u);
    return b;
}
__device__ __forceinline__ void xcd_barrier_complete(unsigned* bar, unsigned x, unsigned& nloc, unsigned& nx) {
    const unsigned G = gridDim.x * gridDim.y * gridDim.z;
    unsigned sum, cnt, mine, sp = 0u;
    for (;;) {
        sum = 0u; cnt = 0u; mine = 0u;
#pragma unroll
        for (unsigned j = 0; j < 16; ++j) { const unsigned c = xb_ld(&bar[XB_XCNT(j)]); sum += c; cnt += (c > 0u) ? 1u : 0u; mine = (j == x) ? c : mine; }
        if (sum == G) break;
        __builtin_amdgcn_s_sleep(1);
        if ((++sp & 255u) == 0u) { if (xb_ld(&bar[XB_TMO])) break; if (sp > XB_SPIN_CAP) { atomicAdd(&bar[XB_TMO], 1u); break; } }
    }
    nloc = mine > 0u ? mine : 1u; nx = cnt > 0u ? cnt : 1u;
}
__device__ __forceinline__ void xcd_barrier(const XcdBarrier& b, int wave) {
    asm volatile("s_waitcnt vmcnt(0)" ::: "memory");
    __syncthreads();
    if (wave == 0 && lane_id() == 0) {
        unsigned* bar = b.bar;
        __builtin_amdgcn_s_waitcnt(0);
        unsigned nloc = b.st[0], nx = b.st[1];
        if (nloc == 0u) { xcd_barrier_complete(bar, b.x, nloc, nx); b.st[0] = nloc; b.st[1] = nx; }
        const unsigned old = xb_add(&bar[XB_XSUB(b.x)], 1u);
        const unsigned gen = old / nloc;
        if (old + 1u == (gen + 1u) * nloc) {
            __builtin_amdgcn_fence(__ATOMIC_RELEASE, "agent");
            asm volatile("s_waitcnt vmcnt(0)" ::: "memory");
            const unsigned og = xb_add(&bar[XB_TOP], 1u);
            const unsigned tg = og / nx;
            if (og + 1u == (tg + 1u) * nx) xb_add(&bar[XB_TOPGEN], 1u);
            else XB_SPIN(xb_ld(&bar[XB_TOPGEN]) == tg, bar);
            __builtin_amdgcn_fence(__ATOMIC_ACQUIRE, "agent");
            xb_add(&bar[XB_XGEN(b.x)], 1u);
            asm volatile("s_waitcnt vmcnt(0)" ::: "memory");
        } else {
            XB_SPIN(xb_ld(&bar[XB_XGEN(b.x)]) == gen, bar);
            __builtin_amdgcn_fence(__ATOMIC_ACQUIRE, "agent");
            asm volatile("s_waitcnt vmcnt(0)" ::: "memory");
        }
    }
    __syncthreads();
}

namespace pg8 {
constexpr int BM = 256, BK = 64, HALF = 128, HTB = HALF * BK * 2, STAGE_BYTES = 8 * HTB, NXCD = 8, WGM = 8;
__host__ __device__ __forceinline__ int lds_byte(int r, int c) { const int st = (r >> 4) * 2 + (c >> 5), rr = r & 15, cc = c & 31, ob = rr * 64 + cc * 2; return st * 1024 + (ob ^ (((ob >> 9) & 1) << 5)); }
__host__ __device__ __forceinline__ void stage_rc(int b, int& R_, int& C_) { const int st = b / 1024, sb = b % 1024, swz = sb ^ (((sb >> 9) & 1) << 5); R_ = (st >> 1) * 16 + swz / 64; C_ = (st & 1) * 32 + (swz % 64) / 2; }
__host__ __device__ __forceinline__ int perm32(int rho) { const int n = rho >> 4, i = rho & 15; return 8 * (i >> 2) + 4 * n + (i & 3); }
struct Unit { int pm, pn, sub; };
struct StaticOrder {
    int nM, nN, nwg, G, c;
    __device__ void init(int M, int N, int G_, int c_) { nM = M / BM; nN = N / BM; nwg = nM * nN; G = G_; c = c_; }
    __device__ bool next(int i, Unit& u) const {
        const long L = (long)i * G + c; if (L >= nwg) return false;
        int wgid = (int)L; { const int q = nwg / NXCD, r = nwg % NXCD, xcd = wgid % NXCD, off = wgid / NXCD; wgid = (xcd < r ? xcd * (q + 1) : r * (q + 1) + (xcd - r) * q) + off; }
        const int nig = WGM * nN, gid = wgid / nig, fm = gid * WGM, gsz = (nM - fm) < WGM ? (nM - fm) : WGM;
        u.pm = fm + ((wgid % nig) % gsz); u.pn = (wgid % nig) / gsz; u.sub = 0; return true;
    }
};
struct PlainLay {
    const h16* A; const h16* Bt; int K;
    __device__ __forceinline__ unsigned a_rowoff(int r) const { return (unsigned)r * (unsigned)K * 2u; }
    __device__ __forceinline__ unsigned b_rowoff(int r) const { return (unsigned)r * (unsigned)K * 2u; }
    __device__ __forceinline__ size_t a_kstep() const { return 128; }
    __device__ __forceinline__ const char* a_ptr(const Unit& u) const { return (const char*)A + (size_t)u.pm * 256 * K * 2; }
    __device__ __forceinline__ const char* b_ptr(const Unit& u) const { return (const char*)Bt + (size_t)u.pn * 256 * K * 2; }
};
struct SplitOrder { int G, c, n; __device__ bool next(int i, Unit& u) const { const int L = i * G + c; if (L >= n) return false; u.pm = 0; u.pn = L & 3; u.sub = L >> 2; return true; } };
struct SplitLay {
    const h16* A; const h16* Bt; int K;
    __device__ __forceinline__ unsigned a_rowoff(int r) const { return (unsigned)r * (unsigned)K * 2u; }
    __device__ __forceinline__ unsigned b_rowoff(int r) const { return (unsigned)r * (unsigned)K * 2u; }
    __device__ __forceinline__ size_t a_kstep() const { return 128; }
    __device__ __forceinline__ const char* a_ptr(const Unit& u) const { return (const char*)A + (size_t)u.sub * 512; }
    __device__ __forceinline__ const char* b_ptr(const Unit& u) const { return (const char*)Bt + (size_t)u.pn * 256 * K * 2 + (size_t)u.sub * 512; }
};

template <class Epi, class Sched, class Lay>
__device__ __forceinline__ void gemm_phase(LAS unsigned char* lds, const int wave, const int K, const Sched& S, const Lay& L, const Epi& E) {
    int tid = wave * 64 + lane_id(); asm volatile("" : "+v"(tid));
    const int wid = wave, lane = tid & 63, wr = wid >> 2, wc = wid & 3, fr = lane & 15, fq = lane >> 4;
    const int nt = K / BK;
    unsigned voffA[2], voffB[2];
#pragma unroll
    for (int i = 0; i < 2; ++i) { int R_, C_; stage_rc(tid * 16 + i * 8192, R_, C_); const int Rb = Epi::PERM ? ((R_ & ~31) + perm32(R_ & 31)) : R_;
        voffA[i] = L.a_rowoff(R_) + (unsigned)C_ * 2u; voffB[i] = L.b_rowoff(Rb) + (unsigned)C_ * 2u; }
    const size_t kstepA = L.a_kstep(), kstepB = (size_t)(BK * 2);
    const size_t hstepA = (size_t)L.a_rowoff(HALF), hstepB = (size_t)L.b_rowoff(HALF);
    const unsigned ldsw = (unsigned)wid * 1024u;
    const int aoff = lds_byte(wr * 64 + fr, fq * 8), boff = lds_byte(wc * 32 + fr, fq * 8);
#define PG8_SA(b, h) (((b) * 2 + (h)) * HTB)
#define PG8_SB(b, h) ((4 + (b) * 2 + (h)) * HTB)
#define PG8_STAGE(bufoff, gbase, voff) do { _Pragma("unroll") for (int _i = 0; _i < 2; ++_i) \
        __builtin_amdgcn_global_load_lds((const unsigned*)((const char*)(gbase) + (voff)[_i]), (LAS unsigned*)(lds + (bufoff) + ldsw + _i * 8192), 16, 0, 0); } while (0)
#define PG8_LDA(dst, b, h) do { _Pragma("unroll") for (int m = 0; m < 4; ++m) _Pragma("unroll") for (int k = 0; k < 2; ++k) dst[m][k] = *(const LAS h8v*)(lds + PG8_SA(b, h) + aoff + m * 2048 + k * 1024); } while (0)
#define PG8_LDB(dst, b, h) do { _Pragma("unroll") for (int n = 0; n < 2; ++n) _Pragma("unroll") for (int k = 0; k < 2; ++k) dst[n][k] = *(const LAS h8v*)(lds + PG8_SB(b, h) + boff + n * 2048 + k * 1024); } while (0)
#define PG8_MMA(ai, bj, At, Bt) do { __builtin_amdgcn_s_setprio(1); _Pragma("unroll") for (int m = 0; m < 4; ++m) _Pragma("unroll") for (int n = 0; n < 2; ++n) _Pragma("unroll") for (int k = 0; k < 2; ++k) \
        acc[ai][bj][m][n] = __builtin_amdgcn_mfma_f32_16x16x32_f16(Bt[n][k], At[m][k], acc[ai][bj][m][n], 0, 0, 0); __builtin_amdgcn_s_setprio(0); } while (0)
#define PG8_WAIT_V(n) asm volatile("s_waitcnt vmcnt(" #n ")" ::: "memory")
#define PG8_WAIT_L(n) asm volatile("s_waitcnt lgkmcnt(" #n ")" ::: "memory")
#define PG8_BAR __builtin_amdgcn_s_barrier()
#define PG8_SCHED __builtin_amdgcn_sched_barrier(0)
    Unit cur, nxt; int ui = 0;
    if (!S.next(0, cur)) return;
    f32x4 acc[2][2][4][2];
#pragma unroll
    for (int a = 0; a < 2; ++a)
#pragma unroll
        for (int b = 0; b < 2; ++b)
#pragma unroll
            for (int m = 0; m < 4; ++m)
#pragma unroll
                for (int n = 0; n < 2; ++n) acc[a][b][m][n] = (f32x4){0.f, 0.f, 0.f, 0.f};
    h8v At[4][2], B0[2][2], B1[2][2];
    const char* cA = L.a_ptr(cur); const char* cB = L.b_ptr(cur);
    PG8_STAGE(PG8_SB(0, 0), cB, voffB); PG8_STAGE(PG8_SB(0, 1), cB + hstepB, voffB); PG8_STAGE(PG8_SA(0, 0), cA, voffA); PG8_STAGE(PG8_SA(0, 1), cA + hstepA, voffA);
    if (wr == 1) PG8_BAR;
    PG8_WAIT_V(2); PG8_BAR;
    PG8_STAGE(PG8_SB(1, 0), cB + kstepB, voffB); PG8_STAGE(PG8_SA(1, 0), cA + kstepA, voffA); PG8_STAGE(PG8_SB(1, 1), cB + hstepB + kstepB, voffB);
    PG8_WAIT_V(6); PG8_BAR;
    for (;;) {
        const bool has_next = S.next(ui + 1, nxt);
        const char* nA = has_next ? L.a_ptr(nxt) : cA; const char* nB = has_next ? L.b_ptr(nxt) : cB;
#pragma unroll 1
        for (int t = 0; t < nt; t += 2) {
            const bool last = (t == nt - 2);
            const char* a1 = cA + (size_t)(t + 1) * kstepA;
            const char* a2 = last ? nA : cA + (size_t)(t + 2) * kstepA; const char* b2 = last ? nB : cB + (size_t)(t + 2) * kstepB;
            const char* a3 = a2 + kstepA; const char* b3 = b2 + kstepB;
            PG8_LDB(B0, 0, 0); PG8_LDB(B1, 0, 1); PG8_SCHED; PG8_LDA(At, 0, 0); PG8_STAGE(PG8_SA(1, 1), a1 + hstepA, voffA);
            PG8_WAIT_V(8); PG8_WAIT_L(0); PG8_BAR; PG8_MMA(0, 0, At, B0); PG8_MMA(0, 1, At, B1); PG8_BAR; PG8_SCHED;
            PG8_LDA(At, 0, 1); PG8_STAGE(PG8_SB(0, 0), b2, voffB); PG8_STAGE(PG8_SB(0, 1), b2 + hstepB, voffB); PG8_STAGE(PG8_SA(0, 0), a2, voffA);
            PG8_WAIT_V(8); PG8_WAIT_L(0); PG8_BAR; PG8_MMA(1, 0, At, B0); PG8_MMA(1, 1, At, B1); PG8_BAR; PG8_SCHED;
            PG8_LDB(B0, 1, 0); PG8_LDB(B1, 1, 1); PG8_SCHED; PG8_LDA(At, 1, 0); PG8_STAGE(PG8_SA(0, 1), a2 + hstepA, voffA);
            PG8_WAIT_V(8); PG8_WAIT_L(0); PG8_BAR; PG8_MMA(0, 0, At, B0); PG8_MMA(0, 1, At, B1); PG8_BAR; PG8_SCHED;
            PG8_LDA(At, 1, 1); PG8_STAGE(PG8_SB(1, 0), b3, voffB); PG8_STAGE(PG8_SB(1, 1), b3 + hstepB, voffB); PG8_STAGE(PG8_SA(1, 0), a3, voffA);
            PG8_WAIT_V(8); PG8_WAIT_L(0); PG8_BAR; PG8_MMA(1, 0, At, B0); PG8_MMA(1, 1, At, B1); PG8_BAR; PG8_SCHED;
        }
        if (wr == 0) PG8_BAR;
        { int fr2 = fr, fq2 = fq; asm volatile("" : "+v"(fr2), "+v"(fq2)); E(acc, cur, wr, wc, fr2, fq2); }
        if (!has_next) break;
#pragma unroll
        for (int a = 0; a < 2; ++a)
#pragma unroll
            for (int b = 0; b < 2; ++b)
#pragma unroll
                for (int m = 0; m < 4; ++m)
#pragma unroll
                    for (int n = 0; n < 2; ++n) acc[a][b][m][n] = (f32x4){0.f, 0.f, 0.f, 0.f};
        cur = nxt; cA = nA; cB = nB; ++ui;
        if (wr == 1) PG8_BAR;
    }
    PG8_WAIT_V(0);
    PG8_BAR;
#undef PG8_SA
#undef PG8_SB
#undef PG8_STAGE
#undef PG8_LDA
#undef PG8_LDB
#undef PG8_MMA
#undef PG8_WAIT_V
#undef PG8_WAIT_L
#undef PG8_BAR
#undef PG8_SCHED
}
}
struct MW {
    unsigned* ctl; float* MOD; float2* ROPE; float* CB;
    h16 *Wglu, *Wup0, *Wup1, *Wdn0, *Wdn1, *Wkv, *Wqg, *Wo, *Wc1k, *Wc1v;
    h16 *XH, *PBs16, *OUTH, *H16, *G16, *UP16, *ACT16, *HKV16, *KV16, *CMPP, *QP16, *QR16, *CMP16, *KC16p, *VC16p, *KC16s, *VC16s;
    float *OUTF, *GATE, *PBp, *PBs, *PART;
    float* out;
};
struct Args { const void* in[38]; MW w; int ph_lo, ph_hi; };
static_assert(sizeof(Args) % 8 == 0, "Args has no tail padding");

struct Frame {
    LAS unsigned char* lds; int wave, G, bid;
    __device__ __forceinline__ int lane() const { return lane_id(); }
    __device__ __forceinline__ int tid() const { return wave * 64 + lane_id(); }
};
#define INP(i) ((const float*)args.in[i])

constexpr int S5_BU = 128 * 144, S5_RS = 80, S5_WAVE_LDS = S5_BU + 128 * S5_RS;
__device__ __forceinline__ int colmap(int map, int n) {
    if (map == 0) return n;
    if (map == 1) { const int hb = n >> 6, j = n & 63; return hb * 64 + 4 * (j >> 3) + (j & 3) + 32 * ((j >> 2) & 1); }
      if (n < 1024) { const int hb = n >> 6, j = n & 63; return hb * 64 + 4 * (j >> 3) + (j & 3) + 32 * ((j >> 2) & 1); }
    return n < NQG ? n : -1;
}
__device__ __forceinline__ void tr_item(const float* W, int ldw, int K, h16* WT, int nblk, int map, int item, int lane) {
    const int kb = item / nblk, nb = item % nblk, n0 = 32 * nb, nl = lane & 31, kh = lane >> 5;
    const int nsrc = colmap(map, n0 + nl);
    const float* src = W + (size_t)(64 * kb + 32 * kh) * ldw + (nsrc >= 0 ? nsrc : 0);
    float v[32];
#pragma unroll
    for (int i = 0; i < 32; ++i) v[i] = src[(size_t)i * ldw];
    h16* dst = WT + (size_t)(n0 + nl) * K + 64 * kb + 32 * kh;
#pragma unroll
    for (int c = 0; c < 4; ++c) { u32x4 o;
        if (nsrc >= 0) { o.x = pkh(v[8 * c], v[8 * c + 1]); o.y = pkh(v[8 * c + 2], v[8 * c + 3]); o.z = pkh(v[8 * c + 4], v[8 * c + 5]); o.w = pkh(v[8 * c + 6], v[8 * c + 7]); } else o = (u32x4){0u, 0u, 0u, 0u};
        *(u32x4*)(dst + 8 * c) = o; }
}
__device__ __forceinline__ void sincos_d(double x, double& s, double& c) {
    const double k = rint(x * 0.63661977236758134308);
    double r = fma(-k, 1.57079632679489655800e+00, x);
    r = fma(-k, 6.12323399573676603587e-17, r);
    const double r2 = r * r;
    double ps = -1.0 / 1307674368000.0;
    ps = fma(ps, r2, 1.0 / 6227020800.0); ps = fma(ps, r2, -1.0 / 39916800.0); ps = fma(ps, r2, 1.0 / 362880.0); ps = fma(ps, r2, -1.0 / 5040.0);
    ps = fma(ps, r2, 1.0 / 120.0); ps = fma(ps, r2, -1.0 / 6.0); ps = fma(ps, r2, 1.0);
    const double sr = ps * r;
    double pc = 1.0 / 20922789888000.0;
    pc = fma(pc, r2, -1.0 / 87178291200.0); pc = fma(pc, r2, 1.0 / 479001600.0); pc = fma(pc, r2, -1.0 / 3628800.0); pc = fma(pc, r2, 1.0 / 40320.0);
    pc = fma(pc, r2, -1.0 / 720.0); pc = fma(pc, r2, 1.0 / 24.0); pc = fma(pc, r2, -0.5);
    const double cr = fma(pc, r2, 1.0);
    const int q = ((int)k) & 3;
    s = (q == 0) ? sr : (q == 1) ? cr : (q == 2) ? -sr : -cr;
    c = (q == 0) ? cr : (q == 1) ? -sr : (q == 2) ? -cr : sr;
}

__device__ __forceinline__ void adaln_item(const Frame& F, const Args& args, int item) {
    const int l = F.lane(), r = l & 31, h = l >> 5, cg = F.wave >> 2, kq = F.wave & 3;
    const int col0 = item * 64 + cg * 32;
    const float* W; int ld;
    if (col0 < 12288) { const int m = col0 / 3072; W = INP(12) + (size_t)m * D * 3072 + (col0 - m * 3072); ld = 3072; } else { W = INP(29) + (col0 - 12288); ld = 2048; }
    const float* c0 = r < BP ? INP(8) + r * D : INP(9) + (r - BP) * D;
    const float* c1 = INP(9) + (24 + (r & 7)) * D;
    f32x16 acc0 = {0.f, 0.f, 0.f, 0.f, 0.f, 0.f, 0.f, 0.f, 0.f, 0.f, 0.f, 0.f, 0.f, 0.f, 0.f, 0.f}, acc1 = acc0;
    for (int ks = 0; ks < 16; ks += 2) {
        float wv[2][8]; f32x4 ca[2][2], cb[2][2];
#pragma unroll
        for (int u = 0; u < 2; ++u) { const int k0 = 256 * kq + 16 * (ks + u) + 8 * h;
#pragma unroll
            for (int j = 0; j < 8; ++j) wv[u][j] = W[(size_t)(k0 + j) * ld + r];
            ca[u][0] = *(const f32x4*)(c0 + k0); ca[u][1] = *(const f32x4*)(c0 + k0 + 4); cb[u][0] = *(const f32x4*)(c1 + k0); cb[u][1] = *(const f32x4*)(c1 + k0 + 4); }
#pragma unroll
        for (int u = 0; u < 2; ++u) { h8v a0, a1, bf;
#pragma unroll
            for (int j = 0; j < 8; ++j) { const float x0 = ca[u][j >> 2][j & 3], x1 = cb[u][j >> 2][j & 3]; a0[j] = (h16)silu(x0); a1[j] = (h16)(r < 8 ? silu(x1) : 0.f); bf[j] = (h16)wv[u][j]; }
            acc0 = __builtin_amdgcn_mfma_f32_32x32x16_f16(a0, bf, acc0, 0, 0, 0); acc1 = __builtin_amdgcn_mfma_f32_32x32x16_f16(a1, bf, acc1, 0, 0, 0); }
    }
    LAS float* red = (LAS float*)F.lds + (cg * 4 + kq) * 1280;
#pragma unroll
    for (int reg = 0; reg < 16; ++reg) red[((reg & 3) + 8 * (reg >> 2) + 4 * h) * 32 + r] = acc0[reg];
#pragma unroll
    for (int reg = 0; reg < 4; ++reg) red[(32 + reg + 4 * h) * 32 + r] = acc1[reg];
    __syncthreads();
    for (int o = F.tid(); o < 2 * 1280; o += NT) { const int g2 = o / 1280, rc = o % 1280, row = rc >> 5, cc = rc & 31; const LAS float* q = (const LAS float*)F.lds + g2 * 4 * 1280 + rc;
        const float sum = (q[0] + q[1280]) + (q[2560] + q[3840]); const int c2 = item * 64 + g2 * 32 + cc;
        args.w.MOD[(size_t)row * MODW + c2] = sum + (c2 < 12288 ? INP(13)[c2] : INP(30)[c2 - 12288]); }
    __syncthreads();
}

__device__ __forceinline__ void p0_prep(const Frame& F, const Args& args) {
    const MW& w = args.w;
    if (F.bid < MODW / 64) adaln_item(F, args, F.bid);
    for (int id = F.bid * NT + F.tid(); id < NROPE * 32; id += F.G * NT) {
        const int idx = id >> 5, i = id & 31;
        const double pos = idx < LP ? (double)idx : (double)(PAST + idx - LP);
        double f = 1.0; for (int j = 0; j < i; ++j) f *= 0.74989420933245582730;
        double s, c; sincos_d(pos * f, s, c);
        w.ROPE[id] = make_float2((float)c, (float)s);
    }
    for (int o = F.bid; o < 256; o += F.G) {
        const int slot = o >> 7, h = o & 127; const float* pe = INP(32) + slot * 2048; const float* w1 = INP(33) + (size_t)slot * 2048 * 128 + h;
        float a = 0.f;
#pragma unroll
        for (int i = 0; i < 4; ++i) { const int k = F.tid() + NT * i; a += pe[k] * w1[(size_t)k * 128]; }
        a = wsum(a);
        LAS float* red = (LAS float*)(F.lds + 131072);
        __syncthreads();
        if (F.lane() == 0) red[F.wave] = a;
        __syncthreads();
        if (F.tid() == 0) { float t = INP(34)[o]; for (int ww = 0; ww < NW; ++ww) t += red[ww]; w.CB[o] = t; }
    }
}

struct RowPass {
    const float* xa; const float* xb;
    const h16* xh; h16* XHout;
    const h16* O; const float* wpost; int gate_off;
    const float* part; int nsplit; const h16* glu_g; const float* glu_b;
    float* Xout;
    const float* w1; int sh1; h16* H1;
    const float* w2; int sh2; h16* H2;
};
struct RowData { f32x4 x[2][4]; h4v o[2][4]; };
constexpr int F_XH = 1, F_O = 2, F_PART = 4, F_GLU = 8, F_XOUT = 16, F_XHOUT = 32, F_H1 = 64, F_H2 = 128;
template <int FL, int NSPLIT, bool SAMPLE, int NR>
__device__ __forceinline__ void row_load(const RowPass& P, int row, int lane, RowData& d) {
    if (FL & F_XH) {
#pragma unroll
        for (int q = 0; q < NR; ++q)
#pragma unroll
            for (int j = 0; j < 4; ++j) { const h4v v = *(const h4v*)(P.xh + (size_t)(row + q) * D + 4 * lane + 256 * j); d.x[q][j] = (f32x4){(float)v[0], (float)v[1], (float)v[2], (float)v[3]}; }
    } else {
        const float* xr = row < RP ? P.xa + (size_t)row * D : P.xb + (size_t)(row - RP) * D;
#pragma unroll
        for (int q = 0; q < NR; ++q)
#pragma unroll
            for (int j = 0; j < 4; ++j) d.x[q][j] = *(const f32x4*)(xr + (size_t)q * D + 4 * lane + 256 * j);
    }
    if ((FL & F_O) && !(SAMPLE && (FL & F_PART))) {
#pragma unroll
        for (int q = 0; q < NR; ++q)
#pragma unroll
            for (int j = 0; j < 4; ++j) d.o[q][j] = *(const h4v*)(P.O + (size_t)(row + q) * D + 4 * lane + 256 * j);
    }
}
template <int FL, int NSPLIT, bool SAMPLE, int NR>
__device__ __forceinline__ void row_body(const RowPass& P, const float* MOD, const int row, const int lane, const RowData& cur) {
    const float* m = MOD + (size_t)modrow(row) * MODW;
    f32x4 wp[4], gt[4], nw[4], sh[4], sc[4];
#define ROW_PARAMS() _Pragma("unroll") for (int j = 0; j < 4; ++j) { const int c = 4 * lane + 256 * j; \
        if (FL & F_O) { wp[j] = *(const f32x4*)(P.wpost + c); gt[j] = *(const f32x4*)(m + P.gate_off + c); } \
        if (FL & F_H1) { nw[j] = *(const f32x4*)(P.w1 + c); sh[j] = *(const f32x4*)(m + P.sh1 + c); sc[j] = *(const f32x4*)(m + P.sh1 + 1024 + c); } }
    if (!(SAMPLE && (FL & F_PART))) { ROW_PARAMS() }
    f32x4 x[NR][4];
#pragma unroll
    for (int q = 0; q < NR; ++q)
#pragma unroll
        for (int j = 0; j < 4; ++j) x[q][j] = cur.x[q][j];
    if (FL & F_O) {
        f32x4 o[NR][4]; float ss[NR];
#pragma unroll
        for (int q = 0; q < NR; ++q) {
            ss[q] = 0.f;
            if (!(SAMPLE && (FL & F_PART))) {
#pragma unroll
                for (int j = 0; j < 4; ++j) { const h4v ov = cur.o[q][j]; o[q][j] = (f32x4){(float)ov[0], (float)ov[1], (float)ov[2], (float)ov[3]}; }
            } else {
#pragma unroll
                for (int j = 0; j < 4; ++j) o[q][j] = (f32x4){0.f, 0.f, 0.f, 0.f};
#pragma unroll 1
                for (int sp0 = 0; sp0 < NSPLIT; sp0 += 4) {
                    f32x4 t[4][4];
#pragma unroll
                    for (int u = 0; u < 4; ++u)
#pragma unroll
                        for (int j = 0; j < 4; ++j) { const int sp = sp0 + u < NSPLIT ? sp0 + u : 0; t[u][j] = *(const f32x4*)(P.part + ((size_t)sp * 256 + (row + q - RP)) * D + 4 * lane + 256 * j); }
#pragma unroll
                    for (int u = 0; u < 4; ++u)
#pragma unroll
                        for (int j = 0; j < 4; ++j) { const float k = sp0 + u < NSPLIT ? 1.f : 0.f; o[q][j] += t[u][j] * k; }
                }
                if (FL & F_GLU) {
#pragma unroll
                    for (int j = 0; j < 4; ++j) { const int c = 4 * lane + 256 * j; const h4v g = *(const h4v*)(P.glu_g + (size_t)(row + q) * D + c); const f32x4 bb = *(const f32x4*)(P.glu_b + c); f32x4 a = o[q][j];
                        a[0] = (float)g[0] * sigm(a[0] + bb[0]); a[1] = (float)g[1] * sigm(a[1] + bb[1]); a[2] = (float)g[2] * sigm(a[2] + bb[2]); a[3] = (float)g[3] * sigm(a[3] + bb[3]); o[q][j] = a; }
                }
            }
#pragma unroll
            for (int j = 0; j < 4; ++j) ss[q] += o[q][j][0] * o[q][j][0] + o[q][j][1] * o[q][j][1] + o[q][j][2] * o[q][j][2] + o[q][j][3] * o[q][j][3];
        }
        if (SAMPLE && (FL & F_PART)) { ROW_PARAMS() }
        float rr[NR];
#pragma unroll
        for (int q = 0; q < NR; ++q) rr[q] = rsqrtf(wsum(ss[q]) * (1.f / D) + EPS);
#pragma unroll
        for (int j = 0; j < 4; ++j)
#pragma unroll
            for (int q = 0; q < NR; ++q) x[q][j] += gt[j] * (o[q][j] * rr[q] * wp[j]);
    }
    if (FL & F_XOUT) {
#pragma unroll
        for (int q = 0; q < NR; ++q)
#pragma unroll
            for (int j = 0; j < 4; ++j) *(f32x4*)(P.Xout + (size_t)(row + q) * D + 4 * lane + 256 * j) = x[q][j];
    }
    if (FL & F_XHOUT) {
#pragma unroll
        for (int q = 0; q < NR; ++q)
#pragma unroll
            for (int j = 0; j < 4; ++j) *(u32x2*)(P.XHout + (size_t)(row + q) * D + 4 * lane + 256 * j) = pkh4(x[q][j]);
    }
    if (FL & F_H1) {
        float rr[NR];
#pragma unroll
        for (int q = 0; q < NR; ++q) { float ss = 0.f;
#pragma unroll
            for (int j = 0; j < 4; ++j) ss += x[q][j][0] * x[q][j][0] + x[q][j][1] * x[q][j][1] + x[q][j][2] * x[q][j][2] + x[q][j][3] * x[q][j][3];
            rr[q] = rsqrtf(wsum(ss) * (1.f / D) + EPS); }
#pragma unroll
        for (int j = 0; j < 4; ++j) { const int c = 4 * lane + 256 * j;
#pragma unroll
            for (int q = 0; q < NR; ++q) *(u32x2*)(P.H1 + (size_t)(row + q) * D + c) = pkh4(x[q][j] * rr[q] * nw[j] * (1.f + sc[j]) + sh[j]); }
        if (FL & F_H2) {
#pragma unroll
            for (int j = 0; j < 4; ++j) { const int c = 4 * lane + 256 * j; nw[j] = *(const f32x4*)(P.w2 + c); sh[j] = *(const f32x4*)(m + P.sh2 + c); sc[j] = *(const f32x4*)(m + P.sh2 + 1024 + c); }
#pragma unroll
            for (int j = 0; j < 4; ++j) { const int c = 4 * lane + 256 * j;
#pragma unroll
                for (int q = 0; q < NR; ++q) *(u32x2*)(P.H2 + (size_t)(row + q) * D + c) = pkh4(x[q][j] * rr[q] * nw[j] * (1.f + sc[j]) + sh[j]); }
        }
    }
}
#undef ROW_PARAMS
template <int FL, int NSPLIT>
__device__ __forceinline__ void row_pass(const Frame& F, const float* MOD, const RowPass& P) {
    const int gw = F.bid * NW + F.wave, NGW = F.G * NW, lane = F.lane();
    if (FL & F_PART) {
        const int gs = (gw & 7) * (NGW >> 3) + (gw >> 3);
        for (int s = gs; s < RS; s += NGW) { RowData d; row_load<FL, NSPLIT, true, 1>(P, RP + s, lane, d); row_body<FL, NSPLIT, true, 1>(P, MOD, RP + s, lane, d); }
    }
    constexpr int NP = (FL & F_PART) ? RP / 2 : R / 2;
    RowData cur, nxt;
    row_load<FL, NSPLIT, false, 2>(P, 2 * (gw < NP ? gw : NP - 1), lane, cur);
#pragma unroll
    for (int q = 0; q < 2; ++q)
#pragma unroll
        for (int j = 0; j < 4; ++j) { asm volatile("" : "+v"(cur.x[q][j])); if (FL & F_O) asm volatile("" : "+v"(cur.o[q][j])); }
#pragma unroll 1
    for (int rp = gw; rp < NP; rp += NGW) {
        const int rn = rp + NGW < NP ? rp + NGW : NP - 1;
        row_load<FL, NSPLIT, false, 2>(P, 2 * rn, lane, nxt);
        row_body<FL, NSPLIT, false, 2>(P, MOD, 2 * rp, lane, cur);
        cur = nxt;
    }
}

constexpr int CW_BGQ = 640;
template <int MODE = 0>
__device__ __forceinline__ void bg_work(const Frame& F, const Args& args) {
    const MW& w = args.w; const float* cache = INP(2); const int* ptab = (const int*)args.in[7]; const int lane = F.lane();
    constexpr int I_GLU = 16 * 32, I_UP = 16 * 176, I_DN = 44 * 32, I_KV = 16 * 48, I_QG = 16 * 40, I_WO = 16 * 32, I_C1 = 16 * 4;
    constexpr int NITEMS = I_GLU + 2 * I_UP + 2 * I_DN + I_KV + I_QG + I_WO + 4 * I_C1, NCONV = BS * PAST / 8;
    constexpr int GRP = 8, NG_T = (NITEMS + GRP - 1) / GRP, NG_C = NCONV / GRP;
    for (int sgi = F.wave * F.G + F.bid;; sgi += 8 * F.G) {
        int gi = 0;
        if (MODE == 1) { gi = sgi; if (gi >= NG_T) break; }
        else { if (lane == 0) gi = (int)__hip_atomic_fetch_add(w.ctl + CW_BGQ, 1u, __ATOMIC_RELAXED, __HIP_MEMORY_SCOPE_AGENT);
               gi = __builtin_amdgcn_readfirstlane(gi);
               if (gi >= NG_T + NG_C) break;
               if (MODE == 2 && gi < NG_T) continue; }
      for (int sub = 0; sub < GRP; ++sub) {
        const int it = gi < NG_T ? gi * GRP + sub : NITEMS + (gi - NG_T) * GRP + sub;
        if (gi < NG_T && it >= NITEMS) break;
        if (it >= NITEMS) {
            const int rp0 = (it - NITEMS) * 8;
            f32x4 v0[8], v1[8];
#pragma unroll
            for (int q = 0; q < 8; ++q) { const int rp = rp0 + q, b = rp >> 13, pos = rp & (PAST - 1);
                const float* src = cache + ((size_t)ptab[b * NPAGES + (pos >> 7)] * PAGE + (pos & 127)) * 1024 + lane * 4; v0[q] = __builtin_nontemporal_load((const f32x4*)src); v1[q] = __builtin_nontemporal_load((const f32x4*)(src + 256)); }
#pragma unroll
            for (int q = 0; q < 8; ++q) { h16* dst = w.CMP16 + (size_t)(rp0 + q) * 512 + lane * 4;
                __builtin_nontemporal_store((u32x2){pkh(v0[q][0], v0[q][1]), pkh(v0[q][2], v0[q][3])}, (u32x2*)dst); __builtin_nontemporal_store((u32x2){pkh(v1[q][0], v1[q][1]), pkh(v1[q][2], v1[q][3])}, (u32x2*)(dst + 256)); }
            continue;
        }
        int r = it;
        if (r < I_GLU) { tr_item(INP(22), D, D, w.Wglu, 32, 0, r, lane); continue; } r -= I_GLU;
        if (r < I_UP) { tr_item(INP(24), F2, D, w.Wup0, 176, 0, r, lane); continue; } r -= I_UP;
        if (r < I_UP) { tr_item(INP(24) + (size_t)D * F2, F2, D, w.Wup1, 176, 0, r, lane); continue; } r -= I_UP;
        if (r < I_DN) { tr_item(INP(27), D, FF, w.Wdn0, 32, 0, r, lane); continue; } r -= I_DN;
        if (r < I_DN) { tr_item(INP(27) + (size_t)FF * D, D, FF, w.Wdn1, 32, 0, r, lane); continue; } r -= I_DN;
        if (r < I_KV) { tr_item(INP(31), NKV, D, w.Wkv, 48, 1, r, lane); continue; } r -= I_KV;
        if (r < I_QG) { tr_item(INP(36), NQG, D, w.Wqg, 40, 2, r, lane); continue; } r -= I_QG;
        if (r < I_WO) { tr_item(INP(37), D, D, w.Wo, 32, 0, r, lane); continue; } r -= I_WO;
        { const int q = r / I_C1, rr = r % I_C1, slot = q >> 1, half = q & 1;
          tr_item(INP(33) + (size_t)slot * 2048 * 128 + (size_t)half * 1024 * 128, 128, 1024, (slot ? w.Wc1v : w.Wc1k) + (size_t)half * 128 * 1024, 4, 0, rr, lane); }
      }
    }
}
__device__ __forceinline__ void s5_disc(const float* lam_re, const float* lam_im, int g, int p, double dt, float& are, float& aim, double& zre, double& zim) {
    const double lr = lam_re[g * P + p], li = lam_im[g * P + p];
    const double mag = exp(lr * dt); double sn, cs; sincos_d(li * dt, sn, cs);
    const double ar = mag * cs, ai = mag * sn, den = lr * lr + li * li;
    zre = ((ar - 1.0) * lr + ai * li) / den; zim = (ai * lr - (ar - 1.0) * li) / den; are = (float)ar; aim = (float)ai;
}
template <bool FULL>
__device__ __forceinline__ void s5_chunk(const h8v (&bf)[4], const h8v (&cf)[4], const f32x4 dsk, const float are, const float aim, float& sr, float& si,
                                         LAS float* BU, LAS unsigned char* S16, const h8v uf, const h4v hv0, const h4v hv1, const int nvalid, h16* gout, const int l) {
    const int r = l & 31, h = l >> 5, q4 = l >> 4, fr = l & 15;
    f32x16 acc[4];
#pragma unroll
    for (int nt = 0; nt < 4; ++nt) { const f32x16 z = {0.f, 0.f, 0.f, 0.f, 0.f, 0.f, 0.f, 0.f, 0.f, 0.f, 0.f, 0.f, 0.f, 0.f, 0.f, 0.f}; acc[nt] = __builtin_amdgcn_mfma_f32_32x32x16_f16(uf, bf[nt], z, 0, 0, 0); }
#pragma unroll
    for (int nt = 0; nt < 4; ++nt)
#pragma unroll
        for (int rg = 0; rg < 4; ++rg) *(LAS f32x4*)(BU + (32 * nt + r) * 36 + 8 * rg + 4 * h) = (f32x4){acc[nt][4 * rg], acc[nt][4 * rg + 1], acc[nt][4 * rg + 2], acc[nt][4 * rg + 3]};
    float xr[32], xi[32];
#pragma unroll
    for (int i = 0; i < 8; ++i) { const f32x4 a = *(const LAS f32x4*)(BU + l * 36 + 4 * i), b = *(const LAS f32x4*)(BU + (64 + l) * 36 + 4 * i);
        xr[4 * i] = a[0]; xr[4 * i + 1] = a[1]; xr[4 * i + 2] = a[2]; xr[4 * i + 3] = a[3]; xi[4 * i] = b[0]; xi[4 * i + 1] = b[1]; xi[4 * i + 2] = b[2]; xi[4 * i + 3] = b[3]; }
#pragma unroll
    for (int t = 0; t < 32; ++t) {
        if (FULL || t < nvalid) { const float t1 = __builtin_fmaf(-aim, si, xr[t]), t2 = __builtin_fmaf(aim, sr, xi[t]); const float nr = __builtin_fmaf(are, sr, t1), ni = __builtin_fmaf(are, si, t2); sr = nr; si = ni; }
        xr[t] = sr; xi[t] = si; }
#pragma unroll
    for (int i = 0; i < 4; ++i) { u32x4 a, b;
        a.x = pkh(xr[8 * i], xr[8 * i + 1]); a.y = pkh(xr[8 * i + 2], xr[8 * i + 3]); a.z = pkh(xr[8 * i + 4], xr[8 * i + 5]); a.w = pkh(xr[8 * i + 6], xr[8 * i + 7]);
        b.x = pkh(xi[8 * i], xi[8 * i + 1]); b.y = pkh(xi[8 * i + 2], xi[8 * i + 3]); b.z = pkh(xi[8 * i + 4], xi[8 * i + 5]); b.w = pkh(xi[8 * i + 6], xi[8 * i + 7]);
        *(LAS u32x4*)(S16 + l * S5_RS + 16 * i) = a; *(LAS u32x4*)(S16 + (64 + l) * S5_RS + 16 * i) = b; }
#pragma unroll
    for (int tt = 0; tt < 2; ++tt) {
        f32x4 y = {0.f, 0.f, 0.f, 0.f};
#pragma unroll
        for (int ks = 0; ks < 4; ++ks) {
            LAS unsigned char* pa = S16 + (32 * ks + 8 * q4 + (fr >> 2)) * S5_RS + (16 * tt + 4 * (fr & 3)) * 2;
            const s16x4 lo = __builtin_amdgcn_ds_read_tr16_b64_v4i16((LAS s16x4*)pa), hi = __builtin_amdgcn_ds_read_tr16_b64_v4i16((LAS s16x4*)(pa + 4 * S5_RS));
            const h8v sf = __builtin_bit_cast(h8v, (__attribute__((ext_vector_type(8))) short){lo[0], lo[1], lo[2], lo[3], hi[0], hi[1], hi[2], hi[3]});
            y = __builtin_amdgcn_mfma_f32_16x16x32_f16(cf[ks], sf, y, 0, 0, 0);
        }
        if (FULL || 16 * tt + fr < nvalid) {
            const h4v hv = tt ? hv1 : hv0;
            f32x4 v;
#pragma unroll
            for (int j = 0; j < 4; ++j) v[j] = gelu_t(y[j] + dsk[j] * (float)hv[j]);
            *(u32x2*)(gout + (16 * tt + fr) * D + 4 * q4) = pkh4(v);
        }
    }
}
template <bool FULL>
__device__ __forceinline__ void s5_item(const Frame& F, const Args& args, int seq, int g, LAS unsigned char* wl) {
    const MW& w = args.w; const int l = F.lane(), r = l & 31, h = l >> 5, q4 = l >> 4, fr = l & 15;
    const double dt = exp((double)INP(16)[g]);
    float are1, aim1, are2, aim2; double zre1, zim1, zre2, zim2;
    s5_disc(INP(14), INP(15), g, r, dt, are1, aim1, zre1, zim1);
    s5_disc(INP(14), INP(15), g, r + 32, dt, are2, aim2, zre2, zim2);
    const float are = h ? are2 : are1, aim = h ? aim2 : aim1;
    h8v bf[4];
#pragma unroll
    for (int nt = 0; nt < 4; ++nt) { const int p = (nt & 1) ? r + 32 : r; const double zr = (nt & 1) ? zre2 : zre1, zi = (nt & 1) ? zim2 : zim1;
        const float* br = INP(17) + (size_t)(g * P + p) * 16 + 8 * h; const float* bi = INP(18) + (size_t)(g * P + p) * 16 + 8 * h;
#pragma unroll
        for (int j = 0; j < 8; ++j) { const double v = (nt >> 1) ? (zr * bi[j] + zi * br[j]) : (zr * br[j] - zi * bi[j]); bf[nt][j] = (h16)(float)v; } }
    h8v cf[4];
#pragma unroll
    for (int ks = 0; ks < 4; ++ks) { const int p0 = 32 * (ks & 1) + 8 * q4; const float* src = ((ks >> 1) ? INP(20) : INP(19)) + (size_t)(g * 16 + fr) * P + p0;
#pragma unroll
        for (int j = 0; j < 8; ++j) cf[ks][j] = (h16)((ks >> 1) ? -src[j] : src[j]); }
    const f32x4 dsk = *(const f32x4*)(INP(21) + g * 16 + 4 * q4);
    float sr = 0.f, si = 0.f;
    LAS float* BU = (LAS float*)wl; LAS unsigned char* S16 = wl + S5_BU;
    if (FULL) {
        const h16* hb = w.H16 + (size_t)seq * LP * D + g * 16; h16* gb = w.G16 + (size_t)seq * LP * D + g * 16;
        const int oa = r * D + 8 * h, ob = fr * D + 4 * q4;
#define S5_LOAD(U, A, B, T) { const int tc = (T) < LP - 32 ? (T) : LP - 32; const h16* pp = hb + (size_t)tc * D; U = *(const h8v*)(pp + oa); A = *(const h4v*)(pp + ob); B = *(const h4v*)(pp + ob + 16 * D); asm volatile("" ::: "memory"); }
#define S5_CHUNK(U, A, B, T) { s5_chunk<true>(bf, cf, dsk, are, aim, sr, si, BU, S16, U, A, B, 32, gb + (size_t)(T) * D, l); asm volatile("" ::: "memory"); }
        h8v u0, u1, u2, u3; h4v a0, a1, a2, a3, b0, b1, b2, b3;
        S5_LOAD(u0, a0, b0, 0) S5_LOAD(u1, a1, b1, 32) S5_LOAD(u2, a2, b2, 64)
#pragma unroll 1
        for (int t0 = 0; t0 < LP; t0 += 128) {
            S5_LOAD(u3, a3, b3, t0 + 96)  S5_CHUNK(u0, a0, b0, t0)
            S5_LOAD(u0, a0, b0, t0 + 128) S5_CHUNK(u1, a1, b1, t0 + 32)
            S5_LOAD(u1, a1, b1, t0 + 160) S5_CHUNK(u2, a2, b2, t0 + 64)
            S5_LOAD(u2, a2, b2, t0 + 192) S5_CHUNK(u3, a3, b3, t0 + 96)
        }
#undef S5_LOAD
#undef S5_CHUNK
        w.out[O_SRE_P + (size_t)(seq * G + g) * P + l] = sr; w.out[O_SIM_P + (size_t)(seq * G + g) * P + l] = si;
    } else {
        const int sb = seq - BP, row0 = RP + sb * LS;
        sr = INP(4)[(sb * G + g) * P + l]; si = INP(5)[(sb * G + g) * P + l];
        h8v uf = {0, 0, 0, 0, 0, 0, 0, 0}; h4v hv0 = {0, 0, 0, 0};
        if (r < LS) uf = *(const h8v*)(w.H16 + (size_t)(row0 + r) * D + g * 16 + 8 * h);
        if (fr < LS) hv0 = *(const h4v*)(w.H16 + (size_t)(row0 + fr) * D + g * 16 + 4 * q4);
        s5_chunk<false>(bf, cf, dsk, are, aim, sr, si, BU, S16, uf, hv0, hv0, LS, w.G16 + (size_t)row0 * D + g * 16, l);
        w.out[O_SRE_S + (size_t)(sb * G + g) * P + l] = sr; w.out[O_SIM_S + (size_t)(sb * G + g) * P + l] = si;
    }
}
__device__ __forceinline__ void s5_phase(const Frame& F, const Args& args) {
#define BGW bg_work<0>
    if (F.wave >= 4) { BGW(F, args); return; }
    LAS unsigned char* wl = F.lds + F.wave * S5_WAVE_LDS;
    if (F.wave < 2) { for (int it = F.wave * F.G + F.bid; it < BP * G; it += 2 * F.G) s5_item<true>(F, args, it / G, it % G, wl); }
    else { for (int it = (F.wave - 2) * F.G + F.bid; it < BS * G; it += 2 * F.G) s5_item<false>(F, args, BP + it / G, it % G, wl); }
    BGW(F, args);
}
struct EpiGlu {
    static constexpr bool PERM = true;
    const h16* Gm; const float* bias; h16* O;
    __device__ __forceinline__ void operator()(const f32x4 (&acc)[2][2][4][2], const pg8::Unit& u, int wr, int wc, int fr, int fq) const {
        const int row0 = u.pm * 256 + wr * 64 + fr, col0 = u.pn * 256 + wc * 32 + 8 * fq;
        f32x4 bs[2][2];
#pragma unroll
        for (int bj = 0; bj < 2; ++bj) { bs[bj][0] = *(const f32x4*)(bias + col0 + bj * 128); bs[bj][1] = *(const f32x4*)(bias + col0 + bj * 128 + 4); }
#pragma unroll
        for (int ai = 0; ai < 2; ++ai) {
            h8v g[4][2];
#pragma unroll
            for (int m = 0; m < 4; ++m)
#pragma unroll
                for (int bj = 0; bj < 2; ++bj) g[m][bj] = *(const h8v*)(Gm + (size_t)(row0 + ai * 128 + m * 16) * D + col0 + bj * 128);
#pragma unroll
            for (int m = 0; m < 4; ++m) { const size_t ro = (size_t)(row0 + ai * 128 + m * 16) * D;
#pragma unroll
                for (int bj = 0; bj < 2; ++bj) { const int c = col0 + bj * 128; const h8v gg = g[m][bj];
                    const f32x4 v0 = acc[ai][bj][m][0] + bs[bj][0], v1 = acc[ai][bj][m][1] + bs[bj][1];
                    u32x4 w; w.x = pkh((float)gg[0] * sigm(v0[0]), (float)gg[1] * sigm(v0[1])); w.y = pkh((float)gg[2] * sigm(v0[2]), (float)gg[3] * sigm(v0[3]));
                    w.z = pkh((float)gg[4] * sigm(v1[0]), (float)gg[5] * sigm(v1[1])); w.w = pkh((float)gg[6] * sigm(v1[2]), (float)gg[7] * sigm(v1[3]));
                    *(u32x4*)(O + ro + c) = w; } }
        }
    }
};
struct EpiH16 {
    static constexpr bool PERM = true;
    h16* O; int ldc;
    __device__ __forceinline__ void operator()(const f32x4 (&acc)[2][2][4][2], const pg8::Unit& u, int wr, int wc, int fr, int fq) const {
        const int row0 = u.pm * 256 + wr * 64 + fr, col0 = u.pn * 256 + wc * 32 + 8 * fq;
#pragma unroll
        for (int ai = 0; ai < 2; ++ai)
#pragma unroll
            for (int m = 0; m < 4; ++m) { h16* rp = O + (size_t)(row0 + ai * 128 + m * 16) * ldc + col0;
#pragma unroll
                for (int bj = 0; bj < 2; ++bj) { const f32x4 v0 = acc[ai][bj][m][0], v1 = acc[ai][bj][m][1];
                    u32x4 w; w.x = pkh(v0[0], v0[1]); w.y = pkh(v0[2], v0[3]); w.z = pkh(v1[0], v1[1]); w.w = pkh(v1[2], v1[3]);
                    *(u32x4*)(rp + bj * 128) = w; } }
    }
};
struct EpiUp {
    static constexpr bool PERM = true;
    h16* O; float* cp; float* cs;
    __device__ __forceinline__ void operator()(const f32x4 (&acc)[2][2][4][2], const pg8::Unit& u, int wr, int wc, int fr, int fq) const {
        const int row0 = u.pm * 256 + wr * 64 + fr, col0 = u.pn * 256 + wc * 32 + 8 * fq;
#pragma unroll
        for (int ai = 0; ai < 2; ++ai)
#pragma unroll
            for (int m = 0; m < 4; ++m) { const int row = row0 + ai * 128 + m * 16; h16* rp = O + (size_t)row * F2 + col0;
                float* st = nullptr;
                if (row < RP) { const int t = row & (LP - 1); if (t >= LP - 2) st = cp + ((size_t)(row >> 11) * 2 + (t - (LP - 2))) * F2 + col0; }
                else { const int t = (row - RP) & 7; if (t >= LS - 2) st = cs + ((size_t)((row - RP) >> 3) * 2 + (t - (LS - 2))) * F2 + col0; }
#pragma unroll
                for (int bj = 0; bj < 2; ++bj) { const f32x4 v0 = acc[ai][bj][m][0], v1 = acc[ai][bj][m][1];
                    u32x4 w; w.x = pkh(v0[0], v0[1]); w.y = pkh(v0[2], v0[3]); w.z = pkh(v1[0], v1[1]); w.w = pkh(v1[2], v1[3]);
                    *(u32x4*)(rp + bj * 128) = w;
                    if (st) { *(f32x4*)(st + bj * 128) = v0; *(f32x4*)(st + bj * 128 + 4) = v1; } } }
    }
};
struct EpiPart {
    static constexpr bool PERM = false;
    float* O;
    __device__ __forceinline__ void operator()(const f32x4 (&acc)[2][2][4][2], const pg8::Unit& u, int wr, int wc, int fr, int fq) const {
        int row0 = wr * 64 + fr; asm volatile("" : "+v"(row0));
        const int col0 = u.pn * 256 + wc * 32 + 4 * fq; float* base = O + (size_t)u.sub * 256 * 1024 + (unsigned)(row0 * 1024 + col0);
#pragma unroll
        for (int ai = 0; ai < 2; ++ai)
#pragma unroll
            for (int m = 0; m < 4; ++m) { float* rp = base + (ai * 128 + m * 16) * 1024;
#pragma unroll
                for (int bj = 0; bj < 2; ++bj)
#pragma unroll
                    for (int n = 0; n < 2; ++n) *(f32x4*)(rp + bj * 128 + n * 16) = acc[ai][bj][m][n]; }
    }
};
__device__ __forceinline__ void conv_phase(const Frame& F, const Args& args, int layer) {
    const MW& w = args.w;
    constexpr int NCHUNK = FF / 8;
    const int ch = F.tid();
    if (ch >= NCHUNK) return;
    const float* cw = (const float*)args.in[25] + (size_t)layer * 3 * F2; const float* cb = (const float*)args.in[26] + (size_t)layer * F2;
    const float* prefix = (const float*)args.in[6] + (size_t)layer * BS * 2 * F2;
    const int j0 = ch * 8;
    float wa[3][8], wg[3][8], ba[8], bg[8];
#pragma unroll
    for (int k = 0; k < 3; ++k)
#pragma unroll
        for (int e = 0; e < 8; ++e) { wa[k][e] = cw[k * F2 + j0 + e]; wg[k][e] = cw[k * F2 + FF + j0 + e]; }
#pragma unroll
    for (int e = 0; e < 8; ++e) { ba[e] = cb[j0 + e]; bg[e] = cb[FF + j0 + e]; }
    constexpr int NSEG_P = RP / 64, NSEG = NSEG_P + BS;
    for (int seg = F.bid; seg < NSEG; seg += F.G) {
        int jj = j0; asm volatile("" : "+v"(jj));
        int row0, nrows; h8v p0a, p1a, p0g, p1g;
        if (seg < NSEG_P) {
            row0 = seg * 64; nrows = 64; const int t0 = row0 & (LP - 1);
            if (t0 == 0) {
#pragma unroll
                for (int e = 0; e < 8; ++e) { p0a[e] = 0; p1a[e] = 0; p0g[e] = 0; p1g[e] = 0; }
            } else {
                p0a = *(const h8v*)(w.UP16 + (size_t)(row0 - 2) * F2 + jj); p1a = *(const h8v*)(w.UP16 + (size_t)(row0 - 1) * F2 + jj);
                p0g = *(const h8v*)(w.UP16 + (size_t)(row0 - 2) * F2 + FF + jj); p1g = *(const h8v*)(w.UP16 + (size_t)(row0 - 1) * F2 + FF + jj);
            }
        } else {
            const int b = seg - NSEG_P; row0 = RP + b * LS; nrows = LS;
#pragma unroll
            for (int e = 0; e < 8; ++e) { p0a[e] = (h16)prefix[((size_t)b * 2 + 0) * F2 + jj + e]; p1a[e] = (h16)prefix[((size_t)b * 2 + 1) * F2 + jj + e];
                                          p0g[e] = (h16)prefix[((size_t)b * 2 + 0) * F2 + FF + jj + e]; p1g[e] = (h16)prefix[((size_t)b * 2 + 1) * F2 + FF + jj + e]; }
        }
        h8v ua[4], ug[4], na[4], ng[4];
#pragma unroll
        for (int q = 0; q < 4; ++q) { ua[q] = *(const h8v*)(w.UP16 + (size_t)(row0 + q) * F2 + jj); ug[q] = *(const h8v*)(w.UP16 + (size_t)(row0 + q) * F2 + FF + jj); }
#pragma unroll
        for (int q = 0; q < 4; ++q) { asm volatile("" : "+v"(ua[q])); asm volatile("" : "+v"(ug[q])); }
#pragma unroll 1
        for (int t = 0; t < nrows; t += 4) {
            { const int tn = t + 4 < nrows ? t + 4 : t;
#pragma unroll
                for (int q = 0; q < 4; ++q) { na[q] = *(const h8v*)(w.UP16 + (size_t)(row0 + tn + q) * F2 + jj); ng[q] = *(const h8v*)(w.UP16 + (size_t)(row0 + tn + q) * F2 + FF + jj); }
                asm volatile("" ::: "memory");
#pragma unroll
                for (int q = 0; q < 4; ++q) { asm volatile("" : "+v"(ua[q])); asm volatile("" : "+v"(ug[q])); }
            }
#pragma unroll
            for (int q = 0; q < 4; ++q) {
                float o[8];
                const h8v r0a = q >= 2 ? ua[q >= 2 ? q - 2 : 0] : (q == 1 ? p1a : p0a), r1a = q >= 1 ? ua[q >= 1 ? q - 1 : 0] : p1a;
                const h8v r0g = q >= 2 ? ug[q >= 2 ? q - 2 : 0] : (q == 1 ? p1g : p0g), r1g = q >= 1 ? ug[q >= 1 ? q - 1 : 0] : p1g;
#pragma unroll
                for (int e = 0; e < 8; ++e) { const float a2 = (float)ua[q][e], g2 = (float)ug[q][e];
                    const float ca = ba[e] + wa[0][e] * (float)r0a[e] + wa[1][e] * (float)r1a[e] + wa[2][e] * a2;
                    const float cg = bg[e] + wg[0][e] * (float)r0g[e] + wg[1][e] * (float)r1g[e] + wg[2][e] * g2;
                    o[e] = silu(cg) * ca; }
                u32x4 pk; pk.x = pkh(o[0], o[1]); pk.y = pkh(o[2], o[3]); pk.z = pkh(o[4], o[5]); pk.w = pkh(o[6], o[7]);
                *(u32x4*)(w.ACT16 + (size_t)(row0 + t + q) * FF + jj) = pk;
            }
            p0a = ua[2]; p1a = ua[3]; p0g = ug[2]; p1g = ug[3];
#pragma unroll
            for (int q = 0; q < 4; ++q) { ua[q] = na[q]; ug[q] = ng[q]; }
        }
    }
}

struct EpiKvQg {
    static constexpr bool PERM = true;
    const float2* ROPE; h16* KV16; h16* CMPP; float* out; h16* QP16; h16* QR16; float* GATE;
    __device__ __forceinline__ void operator()(const f32x4 (&acc)[2][2][4][2], const pg8::Unit& u, int wr, int wc, int fr, int fq) const {
        const int row0 = u.pm * 256 + wr * 64 + fr, col0 = u.pn * 256 + wc * 32 + 8 * fq;
        const int i0 = (col0 & 63) >> 1;
        const bool anyrope = u.sub != 0 || (u.pn >= 2 && u.pn < 5);
#pragma unroll
        for (int ai = 0; ai < 2; ++ai) {
            f32x4 rc[4][2];
            if (anyrope) {
#pragma unroll
                for (int m = 0; m < 4; ++m) { const float2* rp = ROPE + ropeidx(row0 + ai * 128 + m * 16) * 32 + i0; rc[m][0] = *(const f32x4*)rp; rc[m][1] = *(const f32x4*)(rp + 2); }
            }
#pragma unroll
            for (int m = 0; m < 4; ++m) { const int row = row0 + ai * 128 + m * 16;
                const f32x4 cv = {rc[m][0][0], rc[m][0][2], rc[m][1][0], rc[m][1][2]}, sv = {rc[m][0][1], rc[m][0][3], rc[m][1][1], rc[m][1][3]};
#pragma unroll
                for (int bj = 0; bj < 2; ++bj) { const int c = col0 + bj * 128; f32x4 a = acc[ai][bj][m][0], b = acc[ai][bj][m][1];                    const int hb = c >> 6;
                    if (u.sub == 0) {
                        const int s6 = hb >> 2, kvh = hb & 3;
                        if (s6 == 2 || s6 == 4) { const f32x4 ta = a * cv - b * sv, tb = b * cv + a * sv; a = ta; b = tb; }
                        if (s6 < 4) { float* o = out + O_ROWS + (size_t)row * 1024 + s6 * 256 + kvh * 64 + i0; *(f32x4*)o = a; *(f32x4*)(o + 32) = b; }
                        else { const int s2 = s6 - 4; float* o = nullptr;
                            if (row < RP) { const int t = row & (LP - 1); if (t >= LP - WIN) o = out + O_WIN_P + ((size_t)((row >> 11) * WIN + t - (LP - WIN)) * 2 + s2) * 256 + kvh * 64 + i0; }
                            else o = out + O_WIN_S + ((size_t)(row - RP) * 2 + s2) * 256 + kvh * 64 + i0;
                            if (o) { *(f32x4*)o = a; *(f32x4*)(o + 32) = b; } }
                        if (s6 >= 2) { h16* k = KV16 + (size_t)row * 1024 + (s6 - 2) * 256 + kvh * 64 + i0; *(u32x2*)k = pkh4(a); *(u32x2*)(k + 32) = pkh4(b); }
                        else if (row < RP) { h16* k = CMPP + (size_t)row * 512 + s6 * 256 + kvh * 64 + i0; *(u32x2*)k = pkh4(a); *(u32x2*)(k + 32) = pkh4(b); }
                    } else if (c < 1024) {
                        h16* qp = QP16 + (size_t)row * D + hb * 64 + i0; h16* qr = QR16 + (size_t)row * D + hb * 64 + i0;
                        constexpr float QS = 0.125f * 1.4426950408889634f;
                        *(u32x2*)qp = pkh4(a * QS); *(u32x2*)(qp + 32) = pkh4(b * QS);
                        *(u32x2*)qr = pkh4((a * cv - b * sv) * QS); *(u32x2*)(qr + 32) = pkh4((b * cv + a * sv) * QS);
                    } else if (c < NQG) {
                        f32x4 g0, g1;
#pragma unroll
                        for (int e = 0; e < 4; ++e) { g0[e] = sigm(a[e]); g1[e] = sigm(b[e]); }
                        float* gp = GATE + (size_t)row * 48 + (c - 1024); *(f32x4*)gp = g0; *(f32x4*)(gp + 4) = g1;
                    }
                } }
        }
    }
};
struct KvQgOrder {
    pg8::StaticOrder a, b; int G, c;
    __device__ void init(int G_, int c_) { G = G_; c = c_; a.init(R, NKV, 1, 0); b.init(R, 1280, 1, 0); }
    __device__ bool next(int i, pg8::Unit& u) const {
        const int L = i * G + c;
        if (L < a.nwg) { a.next(L, u); u.sub = 0; return true; }
        if (L < a.nwg + b.nwg) { b.next(L - a.nwg, u); u.sub = 1; return true; }
        return false;
    }
};
struct KvQgLay {
    const h16 *A0, *B0, *A1, *B1;
    __device__ __forceinline__ unsigned a_rowoff(int r) const { return (unsigned)r * 2048u; }
    __device__ __forceinline__ unsigned b_rowoff(int r) const { return (unsigned)r * 2048u; }
    __device__ __forceinline__ size_t a_kstep() const { return 128; }
    __device__ __forceinline__ const char* a_ptr(const pg8::Unit& u) const { return (const char*)(u.sub ? A1 : A0) + (size_t)u.pm * 256 * 2048; }
    __device__ __forceinline__ const char* b_ptr(const pg8::Unit& u) const { return (const char*)(u.sub ? B1 : B0) + (size_t)u.pn * 256 * 2048; }
};

struct CmpOrderS {
    int G, c;
    __device__ bool next(int i, pg8::Unit& u) const { const int L = i * G + c; if (L >= 512) return false; u.pn = 0; u.sub = L >> 8; u.pm = L & 255; return true; }
};
struct CmpOrderP {
    int G, c;
    __device__ bool next(int i, pg8::Unit& u) const { const int L = i * G + c; if (L >= 128) return false; u.pn = 0; const int rest = L >> 2; u.sub = (rest >> 4) + 2 * (L & 3); u.pm = rest & 15; return true; }
};
struct CmpLayS {
    const h16 *CS, *Wk, *Wv;
    __device__ __forceinline__ unsigned a_rowoff(int r) const { return (unsigned)(r >> 2) * 16384u + (unsigned)(r & 3) * 128u; }
    __device__ __forceinline__ unsigned b_rowoff(int r) const { return (unsigned)r * 2048u; }
    __device__ __forceinline__ size_t a_kstep() const { return 1024; }
    __device__ __forceinline__ const char* a_ptr(const pg8::Unit& u) const { return (const char*)(CS + ((size_t)(u.pm >> 3) * PAST + (size_t)(u.pm & 7) * 1024) * 512 + (u.sub & 1) * 256); }
    __device__ __forceinline__ const char* b_ptr(const pg8::Unit& u) const { return (const char*)((u.sub & 1) ? Wv : Wk); }
};
struct CmpLayP {
    const h16 *CP, *Wk, *Wv;
    __device__ __forceinline__ unsigned a_rowoff(int r) const { return (unsigned)(r >> 2) * 16384u + (unsigned)(r & 3) * 128u; }
    __device__ __forceinline__ unsigned b_rowoff(int r) const { return (unsigned)r * 2048u; }
    __device__ __forceinline__ size_t a_kstep() const { return 1024; }
    __device__ __forceinline__ const char* a_ptr(const pg8::Unit& u) const { return (const char*)(CP + ((size_t)(u.pm >> 1) * LP + (size_t)(u.pm & 1) * 1024 + (size_t)(u.sub >> 1) * 4) * 512 + (u.sub & 1) * 256); }
    __device__ __forceinline__ const char* b_ptr(const pg8::Unit& u) const { return (const char*)((u.sub & 1) ? Wv : Wk) + (size_t)(u.sub >> 1) * 512; }
};
struct EpiCmpP {
    static constexpr bool PERM = false, AFTER_DRAIN = false;
    float* PB;
    __device__ __forceinline__ void operator()(const f32x4 (&acc)[2][2][4][2], const pg8::Unit& u, int wr, int wc, int fr, int fq) const {
        float* O = PB + (size_t)((u.sub >> 1) * 2 + (u.sub & 1)) * 4096 * 256;
        const int row0 = u.pm * 256 + wr * 64 + fr, col0 = wc * 32 + 4 * fq; float* ob = O + (size_t)row0 * 256 + col0;
#pragma unroll
        for (int ai = 0; ai < 2; ++ai)
#pragma unroll
            for (int m = 0; m < 4; ++m) { float* rp = ob + (ai * 128 + m * 16) * 256;
#pragma unroll
                for (int bj = 0; bj < 2; ++bj)
#pragma unroll
                    for (int n = 0; n < 2; ++n) *(f32x4*)(rp + bj * 128 + n * 16) = acc[ai][bj][m][n]; }
    }
};
struct EpiCmpS {
    static constexpr bool PERM = true, AFTER_DRAIN = false;
    h16* PB;
    __device__ __forceinline__ void operator()(const f32x4 (&acc)[2][2][4][2], const pg8::Unit& u, int wr, int wc, int fr, int fq) const {
        h16* ob = PB + (size_t)(u.sub & 1) * 65536 * 256 + (size_t)(u.pm * 256 + wr * 64 + fr) * 256 + wc * 32 + 8 * fq;
#pragma unroll
        for (int ai = 0; ai < 2; ++ai)
#pragma unroll
            for (int m = 0; m < 4; ++m) { h16* rp = ob + (ai * 128 + m * 16) * 256;
#pragma unroll
                for (int bj = 0; bj < 2; ++bj) { const f32x4 v0 = acc[ai][bj][m][0], v1 = acc[ai][bj][m][1];
                    u32x4 w; w.x = pkh(v0[0], v0[1]); w.y = pkh(v0[2], v0[3]); w.z = pkh(v1[0], v1[1]); w.w = pkh(v1[2], v1[3]);
                    *(u32x4*)(rp + bj * 128) = w; } }
    }
};
constexpr int C2_HST = 272;
__device__ __forceinline__ void cmp2_phase(const Frame& F, const Args& args) {
    const MW& w = args.w; const int l = F.lane(), r = l & 31, h2 = l >> 5;
    const int gw = F.bid * NW + F.wave, NGW = F.G * NW;
    constexpr int TP = BP * NC_P * 4 / 32, TS = BS * NC_S * 4 / 32;
    for (int f = F.tid(); f < 2 * 8 * 2 * 64; f += NT) {
        const int fl = f & 63, nt = (f >> 6) & 1, ks = (f >> 7) & 7, slot = f >> 10;
        const float* w2 = (const float*)args.in[35] + (size_t)slot * 128 * 64 + (size_t)(16 * ks + 8 * (fl >> 5)) * 64 + 32 * nt + (fl & 31);
        u32x4 o; o.x = pkh(w2[0], w2[64]); o.y = pkh(w2[128], w2[192]); o.z = pkh(w2[256], w2[320]); o.w = pkh(w2[384], w2[448]);
        *(LAS u32x4*)(F.lds + (size_t)f * 16) = o;
    }
    __syncthreads();
    LAS unsigned char* HL = F.lds + 32768 + F.wave * (32 * C2_HST);
    const int srow = l >> 4, sc = l & 15;
    for (int tile = gw; tile < 2 * (TP + TS); tile += NGW) {
        const int slot = tile >= TP + TS ? 1 : 0; const int t2 = tile - slot * (TP + TS);
        const bool samp = t2 >= TP; const int tl = samp ? t2 - TP : t2;
        const int nc = samp ? NC_S : NC_P, nch = samp ? 512 : 128;
        h16* KC = samp ? (slot ? w.VC16s : w.KC16s) : (slot ? w.VC16p : w.KC16p);
        const f32x4 c0 = *(const f32x4*)(w.CB + slot * 128 + sc * 8), c1 = *(const f32x4*)(w.CB + slot * 128 + sc * 8 + 4);
        if (samp) {
            h8v xa[8], ya[8];
#pragma unroll
            for (int it = 0; it < 8; ++it) {
                const int rho = tl * 32 + it * 4 + srow; const int kvh = rho & 3, bi = rho >> 2, b = bi / NC_S, i = bi % NC_S;
                const h16* PBh = w.PBs16 + (size_t)slot * 65536 * 256 + ((size_t)(b * 512 + i) * 4 + kvh) * 256 + sc * 8; xa[it] = *(const h8v*)PBh; ya[it] = *(const h8v*)(PBh + 4 * 256 + 128); }
#pragma unroll
            for (int it = 0; it < 8; ++it) { f32x4 x0, x1;
#pragma unroll
                for (int j = 0; j < 4; ++j) { x0[j] = (float)xa[it][j] + (float)ya[it][j]; x1[j] = (float)xa[it][4 + j] + (float)ya[it][4 + j]; }
                u32x4 hv; hv.x = pkh(gelu_t(x0[0] + c0[0]), gelu_t(x0[1] + c0[1])); hv.y = pkh(gelu_t(x0[2] + c0[2]), gelu_t(x0[3] + c0[3]));
                hv.z = pkh(gelu_t(x1[0] + c1[0]), gelu_t(x1[1] + c1[1])); hv.w = pkh(gelu_t(x1[2] + c1[2]), gelu_t(x1[3] + c1[3]));
                *(LAS u32x4*)(HL + (it * 4 + srow) * C2_HST + sc * 16) = hv; }
        } else {
#pragma unroll
            for (int i2 = 0; i2 < 8; i2 += 2) {
                f32x4 t[2][4][4];
#pragma unroll
                for (int d = 0; d < 2; ++d) { const int rho = tl * 32 + (i2 + d) * 4 + srow; const int kvh = rho & 3, bi = rho >> 2, b = bi / NC_P, i = bi % NC_P;
                    const float* p0 = w.PBp + (size_t)slot * 4096 * 256 + ((size_t)(b * 128 + i) * 4 + kvh) * 256 + sc * 8; const float* p1 = p0 + 4 * 256 + 128;
#pragma unroll
                    for (int sl = 0; sl < 4; ++sl) { const size_t so = (size_t)sl * 2 * 4096 * 256; t[d][sl][0] = *(const f32x4*)(p0 + so); t[d][sl][1] = *(const f32x4*)(p1 + so); t[d][sl][2] = *(const f32x4*)(p0 + so + 4); t[d][sl][3] = *(const f32x4*)(p1 + so + 4); } }
#pragma unroll
                for (int d = 0; d < 2; ++d) { f32x4 x0 = t[d][0][0] + t[d][0][1], x1 = t[d][0][2] + t[d][0][3];
#pragma unroll
                    for (int sl = 1; sl < 4; ++sl) { x0 += t[d][sl][0] + t[d][sl][1]; x1 += t[d][sl][2] + t[d][sl][3]; }
                    u32x4 hv; hv.x = pkh(gelu_t(x0[0] + c0[0]), gelu_t(x0[1] + c0[1])); hv.y = pkh(gelu_t(x0[2] + c0[2]), gelu_t(x0[3] + c0[3]));
                    hv.z = pkh(gelu_t(x1[0] + c1[0]), gelu_t(x1[1] + c1[1])); hv.w = pkh(gelu_t(x1[2] + c1[2]), gelu_t(x1[3] + c1[3]));
                    *(LAS u32x4*)(HL + ((i2 + d) * 4 + srow) * C2_HST + sc * 16) = hv; }
            }
        }
        const LAS unsigned char* wfp = F.lds + (size_t)slot * 16384 + l * 16;
        f32x16 acc0 = {0.f, 0.f, 0.f, 0.f, 0.f, 0.f, 0.f, 0.f, 0.f, 0.f, 0.f, 0.f, 0.f, 0.f, 0.f, 0.f}, acc1 = acc0;
#pragma unroll
        for (int ks = 0; ks < 8; ++ks) {
            const h8v hf = *(const LAS h8v*)(HL + r * C2_HST + (16 * ks + 8 * h2) * 2);
            const h8v b0 = *(const LAS h8v*)(wfp + (ks * 2 + 0) * 1024), b1 = *(const LAS h8v*)(wfp + (ks * 2 + 1) * 1024);
            acc0 = __builtin_amdgcn_mfma_f32_32x32x16_f16(hf, b0, acc0, 0, 0, 0);
            acc1 = __builtin_amdgcn_mfma_f32_32x32x16_f16(hf, b1, acc1, 0, 0, 0);
        }
#pragma unroll
        for (int rg = 0; rg < 16; ++rg) { const int orow = tl * 32 + (rg & 3) + 8 * (rg >> 2) + 4 * h2; KC[(size_t)orow * 64 + r] = (h16)acc0[rg]; KC[(size_t)orow * 64 + 32 + r] = (h16)acc1[rg]; }
    }
    __syncthreads();
}
__device__ __forceinline__ float ex2(float x) { return __builtin_amdgcn_exp2f(x); }
constexpr int AT_KST = 144, AT_KB = 64 * AT_KST, AT_VB = 8192, AT_BUF = AT_KB + AT_VB;
__device__ __forceinline__ int kaddr(int row, int c) { return row * AT_KST + c * 16; }
__device__ __forceinline__ constexpr int keyc(int kt, int reg) { return 32 * kt + (reg & 3) + 8 * (reg >> 2); }
__device__ __forceinline__ float xhalf(float v) { return __shfl_xor(v, 32); }
__device__ __forceinline__ void qk64(const LAS unsigned char* KT, const h8v (&qf)[4], f32x16 (&st)[2], int r, int h) {
#pragma unroll
    for (int kt = 0; kt < 2; ++kt) { f32x16 a = {0.f, 0.f, 0.f, 0.f, 0.f, 0.f, 0.f, 0.f, 0.f, 0.f, 0.f, 0.f, 0.f, 0.f, 0.f, 0.f};
#pragma unroll
        for (int ks = 0; ks < 4; ++ks) { const h8v kf = *(const LAS h8v*)(KT + (r * AT_KST + h * 16) + (32 * kt * AT_KST + 32 * ks)); a = __builtin_amdgcn_mfma_f32_32x32x16_f16(kf, qf[ks], a, 0, 0, 0); }
        st[kt] = a; }
}
__device__ __forceinline__ h8v vfrag(const LAS unsigned char* VT, int keybase, int dt, int l) {
    const int h = l >> 5, i = l & 15, q = i >> 2, p = i & 3;
    const LAS unsigned char* a = VT + ((4 * h + q) * 128 + (16 * ((l >> 4) & 1) + 4 * p) * 2) + (keybase * 128 + 64 * dt);
    const s16x4 lo = __builtin_amdgcn_ds_read_tr16_b64_v4i16((LAS s16x4*)a), hi = __builtin_amdgcn_ds_read_tr16_b64_v4i16((LAS s16x4*)(a + 8 * 128));
    return __builtin_bit_cast(h8v, (__attribute__((ext_vector_type(8))) short){lo[0], lo[1], lo[2], lo[3], hi[0], hi[1], hi[2], hi[3]});
}
__device__ __forceinline__ void pv64(const f32x16 (&p)[2], const LAS unsigned char* VT, f32x16 (&o)[2], int l) {
#pragma unroll
    for (int kt = 0; kt < 2; ++kt)
#pragma unroll
        for (int s = 0; s < 2; ++s) { h8v pf;
#pragma unroll
            for (int j = 0; j < 8; ++j) pf[j] = (h16)p[kt][8 * s + j];
#pragma unroll
            for (int dt = 0; dt < 2; ++dt) { const h8v vf = vfrag(VT, 32 * kt + 16 * s, dt, l); o[dt] = __builtin_amdgcn_mfma_f32_32x32x16_f16(vf, pf, o[dt], 0, 0, 0); } }
}
struct AttSt { float mrun, lrun; f32x16 o[2]; };
__device__ __forceinline__ void att_reset(AttSt& S) { S.mrun = NEG; S.lrun = 0.f;
#pragma unroll
    for (int dt = 0; dt < 2; ++dt) S.o[dt] = (f32x16){0.f, 0.f, 0.f, 0.f, 0.f, 0.f, 0.f, 0.f, 0.f, 0.f, 0.f, 0.f, 0.f, 0.f, 0.f, 0.f}; }
template <class MaskF> __device__ __forceinline__ void sm_pv64(f32x16 (&st)[2], const LAS unsigned char* VT, AttSt& S, bool anymask, MaskF valid, int l) {
    float mx = NEG;
    if (anymask) {
#pragma unroll
        for (int kt = 0; kt < 2; ++kt)
#pragma unroll
            for (int reg = 0; reg < 16; ++reg) { const float v = valid(keyc(kt, reg)) ? st[kt][reg] : NEG; st[kt][reg] = v; mx = fmaxf(mx, v); }
    } else {
#pragma unroll
        for (int kt = 0; kt < 2; ++kt)
#pragma unroll
            for (int reg = 0; reg < 16; reg += 2) mx = fmaxf(mx, fmaxf(st[kt][reg], st[kt][reg + 1]));
    }
    mx = fmaxf(mx, xhalf(mx));
    const float mnew = fmaxf(S.mrun, mx), alpha = ex2(S.mrun - mnew); float ls = 0.f;
    if (anymask) {
#pragma unroll
        for (int kt = 0; kt < 2; ++kt)
#pragma unroll
            for (int reg = 0; reg < 16; ++reg) { const float v = st[kt][reg]; const float p = (v <= 0.5f * NEG) ? 0.f : ex2(v - mnew); st[kt][reg] = p; ls += p; }
    } else {
#pragma unroll
        for (int kt = 0; kt < 2; ++kt)
#pragma unroll
            for (int reg = 0; reg < 16; ++reg) { const float p = ex2(st[kt][reg] - mnew); st[kt][reg] = p; ls += p; }
    }
    S.lrun = S.lrun * alpha + ls; S.mrun = mnew;
    if (!__all(alpha == 1.f)) {
#pragma unroll
        for (int dt = 0; dt < 2; ++dt)
#pragma unroll
            for (int reg = 0; reg < 16; ++reg) S.o[dt][reg] *= alpha; }
    pv64(st, VT, S.o, l);
}
__device__ __forceinline__ void att_fold(f32x16 (&tot)[2], const AttSt& S, float gate) {
    const float lt = S.lrun + xhalf(S.lrun); const float sc = lt > 0.f ? gate / lt : 0.f;
#pragma unroll
    for (int dt = 0; dt < 2; ++dt)
#pragma unroll
        for (int reg = 0; reg < 16; ++reg) tot[dt][reg] += sc * S.o[dt][reg];
}
__device__ __forceinline__ void att_store(const f32x16 (&tot)[2], h16* dst  , int h) {
#pragma unroll
    for (int dt = 0; dt < 2; ++dt)
#pragma unroll
        for (int g4 = 0; g4 < 4; ++g4) { const int d0 = 32 * dt + 8 * g4 + 4 * h;
            *(u32x2*)(dst + d0) = pkh4((f32x4){tot[dt][4 * g4], tot[dt][4 * g4 + 1], tot[dt][4 * g4 + 2], tot[dt][4 * g4 + 3]}); }
}

constexpr int ATP_SCI = 4 * AT_BUF, ATP_SCL = ATP_SCI + 32768, ATP_TOT = ATP_SCL + 32768, ATP_MASK = ATP_TOT + 8192;
__device__ __forceinline__ void attn_prompt_unit(const Frame& F, const Args& args, int b, int kvh, int m) {
    const MW& w = args.w; int l = F.lane(); asm volatile("" : "+v"(l));
    const int r = l & 31, h = l >> 5, qsub = F.wave >> 2, gh = F.wave & 3, head = kvh * 4 + gh;
    const int qloc = 32 * qsub + r, qpos = 64 * m + qloc, qrow = b * LP + qpos;
    LAS unsigned char* L = F.lds;
    LAS float* SCI = (LAS float*)(L + ATP_SCI); LAS float* SCL = (LAS float*)(L + ATP_SCL); LAS float* TOT = (LAS float*)(L + ATP_TOT); LAS unsigned* MASK = (LAS unsigned*)(L + ATP_MASK);
    int tid = F.tid(); asm volatile("" : "+v"(tid));
    const int srow = tid >> 3, sc8 = tid & 7;
#pragma unroll
    for (int T = 0; T < 2; ++T) { const int i = 64 * T + srow; u32x4 kk = {0u, 0u, 0u, 0u}, vv = {0u, 0u, 0u, 0u};
        if (i < NC_P) { const size_t o = ((size_t)(b * NC_P + i) * 4 + kvh) * 64 + sc8 * 8; kk = *(const u32x4*)(w.KC16p + o); vv = *(const u32x4*)(w.VC16p + o); }
        *(LAS u32x4*)(L + T * AT_BUF + kaddr(srow, sc8)) = kk; *(LAS u32x4*)(L + T * AT_BUF + AT_KB + srow * 128 + sc8 * 16) = vv; }
    if (tid < 64) MASK[tid] = 0u;
    const float* gt = w.GATE + (size_t)qrow * 48;
    h8v qf[4];
#pragma unroll
    for (int ks = 0; ks < 4; ++ks) qf[ks] = *(const h8v*)(w.QP16 + (size_t)qrow * D + head * 64 + 16 * ks + 8 * h);
    __syncthreads();
    f32x16 tot[2];
    {
        f32x16 s0[2], s1[2]; qk64(L, qf, s0, r, h); qk64(L + AT_BUF, qf, s1, r, h);
        const int qc = qpos - 31 - 64 * h, c1lim = NC_P - 64 - 4 * h;
        float mx = NEG;
#pragma unroll
        for (int kt = 0; kt < 2; ++kt)
#pragma unroll
            for (int reg = 0; reg < 16; ++reg) { const int kc = keyc(kt, reg);
                const float v0 = (16 * kc <= qc) ? s0[kt][reg] : NEG, v1 = (kc < c1lim && 16 * kc + 1024 <= qc) ? s1[kt][reg] : NEG; s0[kt][reg] = v0; s1[kt][reg] = v1; mx = fmaxf(mx, fmaxf(v0, v1)); }
        mx = fmaxf(mx, xhalf(mx)); float sum = 0.f;
#pragma unroll
        for (int kt = 0; kt < 2; ++kt)
#pragma unroll
            for (int reg = 0; reg < 16; ++reg) { const float p0 = (s0[kt][reg] <= 0.5f * NEG) ? 0.f : ex2(s0[kt][reg] - mx), p1 = (s1[kt][reg] <= 0.5f * NEG) ? 0.f : ex2(s1[kt][reg] - mx); s0[kt][reg] = p0; s1[kt][reg] = p1; sum += p0 + p1; }
        sum += xhalf(sum); const float inv = sum > 0.f ? 1.f / sum : 0.f;
#pragma unroll
        for (int kt = 0; kt < 2; ++kt)
#pragma unroll
            for (int reg = 0; reg < 16; ++reg) { s0[kt][reg] *= inv; s1[kt][reg] *= inv; }
        { LAS float* sci = SCI + (gh * 32 + h) * 64 + qloc; LAS float* scl = SCL + (gh * 32 + h) * 64 + qloc;
#pragma unroll
        for (int kt = 0; kt < 2; ++kt)
#pragma unroll
            for (int g4 = 0; g4 < 4; ++g4) { constexpr int dummy = 0; (void)dummy; const int o0 = (8 * kt + 2 * g4) * 64, o1 = o0 + 16 * 64;
                sci[o0] = 2.f * (s0[kt][4 * g4] + s0[kt][4 * g4 + 1] + s0[kt][4 * g4 + 2]) + s0[kt][4 * g4 + 3]; scl[o0] = s0[kt][4 * g4 + 3];
                sci[o1] = 2.f * (s1[kt][4 * g4] + s1[kt][4 * g4 + 1] + s1[kt][4 * g4 + 2]) + s1[kt][4 * g4 + 3]; scl[o1] = s1[kt][4 * g4 + 3]; } }
        f32x16 oc[2];
#pragma unroll
        for (int dt = 0; dt < 2; ++dt) oc[dt] = (f32x16){0.f, 0.f, 0.f, 0.f, 0.f, 0.f, 0.f, 0.f, 0.f, 0.f, 0.f, 0.f, 0.f, 0.f, 0.f, 0.f};
        pv64(s0, L + AT_KB, oc, l); pv64(s1, L + AT_BUF + AT_KB, oc, l);
#pragma unroll
        for (int dt = 0; dt < 2; ++dt)
#pragma unroll
            for (int reg = 0; reg < 16; ++reg) tot[dt][reg] = gt[head] * oc[dt][reg];
    }
#pragma unroll
    for (int ks = 0; ks < 4; ++ks) qf[ks] = *(const h8v*)(w.QR16 + (size_t)qrow * D + head * 64 + 16 * ks + 8 * h);
    __syncthreads();
    {
        const int q = l, jg = F.wave; float me[4];
        const LAS float* sci = SCI + 4 * jg * 64 + q; const LAS float* scl = SCL + (4 * jg - 1) * 64 + q; LAS float* totw = TOT + 4 * jg * 64 + q;
#pragma unroll
        for (int e = 0; e < 4; ++e) { const int j = 4 * jg + e; float a = 0.f;
#pragma unroll
            for (int g = 0; g < 4; ++g) { a += sci[(g * 32 + e) * 64]; if (j > 0) a += scl[(g * 32 + e) * 64]; }
            const bool forced = (j == 0) || (j == m) || (j == m - 1);
            me[e] = forced ? INFINITY : (j <= m ? a : -INFINITY); totw[e * 64] = me[e]; }
        __syncthreads();
        unsigned bits = 0u;
        if (m < NSEL) {
#pragma unroll
            for (int e = 0; e < 4; ++e) if (4 * jg + e <= m) bits |= 1u << (4 * jg + e);
        } else {
            int rank[4] = {0, 0, 0, 0};
#pragma unroll 1
            for (int j2 = 0; j2 < 32; ++j2) { const float o = (TOT + q)[j2 * 64];
#pragma unroll
                for (int e = 0; e < 4; ++e) rank[e] += (o > me[e] || (o == me[e] && j2 < 4 * jg + e)) ? 1 : 0; }
#pragma unroll
            for (int e = 0; e < 4; ++e) if (rank[e] < NSEL) bits |= 1u << (4 * jg + e);
        }
        if (bits) atomicOr((unsigned*)(MASK + q), bits);
    }
    __syncthreads();
    const unsigned mq = MASK[qloc];
    const int n_sel = m + 1, w0 = m > 8 ? m - 8 : 0, n_all = n_sel + (m - w0 + 1);
    const h16* kvb = w.KV16 + (size_t)b * LP * 1024 + kvh * 64 + sc8 * 8;
    u32x4 kk0, vv0, kk1, vv1;
#define AT_LOAD1(t, K_, V_) do { if ((t) < n_all) { const int jb_ = (t) < n_sel ? (t) : w0 + (t) - n_sel; const h16* p_ = kvb + (size_t)(64 * jb_ + srow) * 1024 + ((t) < n_sel ? 0 : 512); K_ = *(const u32x4*)p_; V_ = *(const u32x4*)(p_ + 256); } } while (0)
#define AT_LOAD(p) do { AT_LOAD1(2 * (p), kk0, vv0); AT_LOAD1(2 * (p) + 1, kk1, vv1); } while (0)
#define AT_PUT(buf) do { int bo_ = (buf) * 2 * AT_BUF; asm volatile("" : "+v"(bo_)); LAS unsigned char* q_ = L + bo_; \
        *(LAS u32x4*)(q_ + kaddr(srow, sc8)) = kk0; *(LAS u32x4*)(q_ + AT_KB + srow * 128 + sc8 * 16) = vv0; \
        *(LAS u32x4*)(q_ + AT_BUF + kaddr(srow, sc8)) = kk1; *(LAS u32x4*)(q_ + AT_BUF + AT_KB + srow * 128 + sc8 * 16) = vv1; } while (0)
    const int np = (n_all + 1) >> 1;
    AT_LOAD(0); AT_PUT(0);
    if (np > 1) AT_LOAD(1);
    __syncthreads();
    AttSt S; att_reset(S);
    const int qd = qloc - 4 * h;
    for (int pp = 0; pp < np; ++pp) {
        if (pp + 1 < np) AT_PUT((pp + 1) & 1);
        if (pp + 2 < np) AT_LOAD(pp + 2);
#pragma unroll
        for (int u2 = 0; u2 < 2; ++u2) {
            const int t = 2 * pp + u2;
            if (t < n_all) {
                int bo = ((pp & 1) * 2 + u2) * AT_BUF; asm volatile("" : "+v"(bo));
                const LAS unsigned char* KT = L + bo;
                if (t == n_sel) { att_fold(tot, S, gt[16 + head]); att_reset(S); }
                if (t < n_sel) {
                    const int jb = t; const bool selq = (mq >> jb) & 1u;
                    if (__any(selq)) { f32x16 st[2]; qk64(KT, qf, st, r, h); const bool diag = jb == m;
                        sm_pv64(st, KT + AT_KB, S, diag || !__all(selq), [&](int kc) { return selq && (!diag || kc <= qd); }, l); }
                } else {
                    const int jb = w0 + t - n_sel; f32x16 st[2]; qk64(KT, qf, st, r, h); const bool diag = jb == m, far = jb == m - 8;
                    sm_pv64(st, KT + AT_KB, S, diag || far, [&](int kc) { return diag ? kc <= qd : (far ? kc > qd : true); }, l);
                }
            }
        }
        __syncthreads();
    }
#undef AT_LOAD1
    att_fold(tot, S, gt[32 + head]);
#undef AT_LOAD
#undef AT_PUT
    att_store(tot, w.G16 + (size_t)qrow * D + head * 64, h);
}

constexpr int ATS_SM = 8 * AT_BUF;
__device__ __forceinline__ void wave_load_f32(LAS unsigned char* WK, LAS unsigned char* WV, const float* base  , unsigned stride, int l) {
    const unsigned c16 = l & 15, kq = l >> 4; const unsigned lo = kq * stride + 4u * c16;
    LAS unsigned char* wk = WK + kq * AT_KST + (c16 >> 1) * 16 + (c16 & 1) * 8; LAS unsigned char* wv = WV + kq * 128 + c16 * 8;
#pragma unroll
    for (int half = 0; half < 2; ++half) { f32x4 v[16];
#pragma unroll
        for (int i = 0; i < 16; ++i) v[i] = *(const f32x4*)(base + (lo + (unsigned)(4 * i) * stride + (unsigned)half * 256u));
#pragma unroll
        for (int i = 0; i < 16; ++i) { const u32x2 pk = pkh4(v[i]);
            if (half == 0) *(LAS u32x2*)(wk + 4 * i * AT_KST) = pk; else *(LAS u32x2*)(wv + 4 * i * 128) = pk; } }
}
__device__ __forceinline__ void wave_load_new(LAS unsigned char* WK, LAS unsigned char* WV, const h16* kv16rows  , int kslot, int l) {
    const u32x4 z = {0u, 0u, 0u, 0u};
#pragma unroll
    for (int it = 0; it < 8; ++it) { *(LAS u32x4*)(WK + (it * 64 + l) * 16) = z; *(LAS u32x4*)(WV + (it * 64 + l) * 16) = z; }
    const int row = l >> 3, c = l & 7; const h16* p = kv16rows + (size_t)row * 1024 + kslot * 256 + c * 8;
    const u32x4 kk = *(const u32x4*)p, vv = *(const u32x4*)(p + 256);
    *(LAS u32x4*)(WK + kaddr(row, c)) = kk; *(LAS u32x4*)(WV + row * 128 + c * 16) = vv;
}
__device__ __forceinline__ void attn_sample_unit(const Frame& F, const Args& args, int b, int kvh) {
    const MW& w = args.w; int l = F.lane(); asm volatile("" : "+v"(l));
    const int r = l & 31, h = l >> 5, W = F.wave, t = r >> 2, gh = r & 3, head = kvh * 4 + gh;
    const int qrow = RP + b * LS + t, qpos = PAST + t;
    LAS unsigned char* L = F.lds; LAS unsigned char* WK = L + W * AT_BUF; LAS unsigned char* WV = WK + AT_KB;
    LAS float* WMX = (LAS float*)(L + ATS_SM); LAS float* WSM = WMX + 256; LAS float* WMX2 = WMX + 512; LAS float* WSM2 = WMX + 768; LAS float* WMX3 = WMX + 1024; LAS float* WSM3 = WMX + 1280;
    LAS unsigned* SELW = (LAS unsigned*)(L + ATS_SM + 6144); LAS float* TOTw = (LAS float*)(WK + 4096);
    const float* cache = (const float*)args.in[2]; const float* cwin = (const float*)args.in[3]; const int* ptab = (const int*)args.in[7];
    const float* gt = w.GATE + (size_t)qrow * 48;
#pragma unroll
    for (int it = 0; it < 8; ++it) { const int id = it * 64 + l, row = id >> 3, c = id & 7, i = 64 * W + row; u32x4 kk = {0u, 0u, 0u, 0u}, vv = {0u, 0u, 0u, 0u};
        if (i < NC_S) { const size_t o = ((size_t)(b * NC_S + i) * 4 + kvh) * 64 + c * 8; kk = *(const u32x4*)(w.KC16s + o); vv = *(const u32x4*)(w.VC16s + o); }
        *(LAS u32x4*)(WK + kaddr(row, c)) = kk; *(LAS u32x4*)(WV + row * 128 + c * 16) = vv; }
    h8v qf[4];
#pragma unroll
    for (int ks = 0; ks < 4; ++ks) qf[ks] = *(const h8v*)(w.QP16 + (size_t)qrow * D + head * 64 + 16 * ks + 8 * h);
    f32x16 tot[2];
    {
        f32x16 st[2]; qk64(WK, qf, st, r, h);
        const int clim = NC_S - 64 * W - 4 * h, qc = qpos - 31 - 1024 * W - 64 * h;
        float mx = NEG;
#pragma unroll
        for (int kt = 0; kt < 2; ++kt)
#pragma unroll
            for (int reg = 0; reg < 16; ++reg) { const int kc = keyc(kt, reg); const float v = (kc < clim && 16 * kc <= qc) ? st[kt][reg] : NEG; st[kt][reg] = v; mx = fmaxf(mx, v); }
        mx = fmaxf(mx, xhalf(mx));
        if (h == 0) WMX[W * 32 + r] = mx;
        __syncthreads();
        float gm = NEG;
#pragma unroll
        for (int ww = 0; ww < 8; ++ww) gm = fmaxf(gm, WMX[ww * 32 + r]);
        float sum = 0.f;
#pragma unroll
        for (int kt = 0; kt < 2; ++kt)
#pragma unroll
            for (int reg = 0; reg < 16; ++reg) { const float p = (st[kt][reg] <= 0.5f * NEG) ? 0.f : ex2(st[kt][reg] - gm); st[kt][reg] = p; sum += p; }
        sum += xhalf(sum);
        if (h == 0) WSM[W * 32 + r] = sum;
        __syncthreads();
        float ts = 0.f;
#pragma unroll
        for (int ww = 0; ww < 8; ++ww) ts += WSM[ww * 32 + r];
        const float inv = ts > 0.f ? 1.f / ts : 0.f;
#pragma unroll
        for (int kt = 0; kt < 2; ++kt)
#pragma unroll
            for (int reg = 0; reg < 16; ++reg) st[kt][reg] *= inv;
        LAS float* SCw = (LAS float*)WK;
#pragma unroll
        for (int kt = 0; kt < 2; ++kt)
#pragma unroll
            for (int g4 = 0; g4 < 4; ++g4) { const int ml = 8 * kt + 2 * g4 + h;
                SCw[ml * 32 + r] = 2.f * (st[kt][4 * g4] + st[kt][4 * g4 + 1] + st[kt][4 * g4 + 2]) + st[kt][4 * g4 + 3]; SCw[512 + ml * 32 + r] = st[kt][4 * g4 + 3]; }
        f32x16 oc[2];
#pragma unroll
        for (int dt = 0; dt < 2; ++dt) oc[dt] = (f32x16){0.f, 0.f, 0.f, 0.f, 0.f, 0.f, 0.f, 0.f, 0.f, 0.f, 0.f, 0.f, 0.f, 0.f, 0.f, 0.f};
        pv64(st, WV, oc, l);
#pragma unroll
        for (int dt = 0; dt < 2; ++dt)
#pragma unroll
            for (int reg = 0; reg < 16; ++reg) tot[dt][reg] = gt[head] * oc[dt][reg];
    }
    __syncthreads();
    {
        float me[3];
#pragma unroll
        for (int e = 0; e < 3; ++e) { const int j = e < 2 ? l + 64 * e : 128; float a = 0.f;
            if (e < 2 || l == 0) {
#pragma unroll
                for (int g = 0; g < 4; ++g) { const int col = 4 * W + g;
                    if (j < 128) a += ((const LAS float*)(L + (j >> 4) * AT_BUF))[(j & 15) * 32 + col];
                    if (j > 0) a += ((const LAS float*)(L + ((j - 1) >> 4) * AT_BUF))[512 + ((j - 1) & 15) * 32 + col]; }
                const bool forced = (j == 0) || (j == 128) || (j == 127);
                me[e] = forced ? INFINITY : a; TOTw[j] = me[e];
            } else me[e] = -INFINITY; }
        asm volatile("s_waitcnt lgkmcnt(0)" ::: "memory");
        int rank[3] = {0, 0, 0};
#pragma unroll 1
        for (int j2 = 0; j2 < NS_S; ++j2) { const float o = TOTw[j2];
#pragma unroll
            for (int e = 0; e < 3; ++e) { const int j = e < 2 ? l + 64 * e : 128; rank[e] += (o > me[e] || (o == me[e] && j2 < j)) ? 1 : 0; } }
        const unsigned long long b0 = __ballot(rank[0] < NSEL), b1 = __ballot(rank[1] < NSEL), b2 = __ballot(l == 0 && rank[2] < NSEL);
        if (l == 0) { SELW[W * 8 + 0] = (unsigned)b0; SELW[W * 8 + 1] = (unsigned)(b0 >> 32); SELW[W * 8 + 2] = (unsigned)b1; SELW[W * 8 + 3] = (unsigned)(b1 >> 32); SELW[W * 8 + 4] = (unsigned)(b2 & 1ull); }
    }
    __syncthreads();
    const h16* qrp = w.QR16 + (size_t)qrow * D + head * 64 + 8 * h;
#define ATS_LOADQ() do { asm volatile("" ::: "memory"); _Pragma("unroll") for (int ks = 0; ks < 4; ++ks) qf[ks] = *(const h8v*)(qrp + 16 * ks); } while (0)
    const h16* newrows = w.KV16 + (size_t)(RP + b * LS) * 1024 + kvh * 64;
    AttSt S; att_reset(S);
    const int td = t - 4 * h, tw = t - 64 * W - 4 * h;
    for (int jb = W; jb < NS_S; jb += 8) {
        unsigned uw = 0u;
#pragma unroll
        for (int tt = 0; tt < 8; ++tt) uw |= SELW[tt * 8 + (jb >> 5)];
        if (!((uw >> (jb & 31)) & 1u)) continue;
        if (jb < 128) { const int page = __builtin_amdgcn_readfirstlane(ptab[b * NPAGES + (jb >> 1)]);
            const float* base = cache + (((size_t)page * PAGE + (jb & 1) * 64) * 4 + 2) * 256 + kvh * 64;
            wave_load_f32(WK, WV, base, 1024u, l); }
        else wave_load_new(WK, WV, newrows, 0, l);
        const unsigned sw = SELW[t * 8 + (jb >> 5)];
        const bool selq = (sw >> (jb & 31)) & 1u; const bool isnew = jb == 128;
        ATS_LOADQ(); f32x16 st[2]; qk64(WK, qf, st, r, h);
        sm_pv64(st, WV, S, true, [&](int kc) { return selq && (!isnew || kc <= td); }, l);
    }
    { const float lt = S.lrun + xhalf(S.lrun); if (h == 0) { WMX2[W * 32 + r] = S.mrun; WSM2[W * 32 + r] = lt; } }
    __syncthreads();
    { float gm = NEG;
#pragma unroll
      for (int ww = 0; ww < 8; ++ww) gm = fmaxf(gm, WMX2[ww * 32 + r]);
      float gl = 0.f;
#pragma unroll
      for (int ww = 0; ww < 8; ++ww) gl += WSM2[ww * 32 + r] * ex2(WMX2[ww * 32 + r] - gm);
      const float f = gl > 0.f ? gt[16 + head] * ex2(S.mrun - gm) / gl : 0.f;
#pragma unroll
      for (int dt = 0; dt < 2; ++dt)
#pragma unroll
          for (int reg = 0; reg < 16; ++reg) tot[dt][reg] += f * S.o[dt][reg]; }
    att_reset(S);
    { const float* base = cwin + ((size_t)(b * WIN + 64 * W) * 2) * 256 + kvh * 64;
      wave_load_f32(WK, WV, base, 512u, l);
      ATS_LOADQ(); f32x16 st[2]; qk64(WK, qf, st, r, h);
      sm_pv64(st, WV, S, W == 0, [&](int kc) { return kc > tw; }, l); }
    if (W == 0) { wave_load_new(WK, WV, newrows, 2, l); ATS_LOADQ(); f32x16 st[2]; qk64(WK, qf, st, r, h); sm_pv64(st, WV, S, true, [&](int kc) { return kc <= td; }, l); }
    { const float lt = S.lrun + xhalf(S.lrun); if (h == 0) { WMX3[W * 32 + r] = S.mrun; WSM3[W * 32 + r] = lt; } }
    __syncthreads();
    { float gm = NEG;
#pragma unroll
      for (int ww = 0; ww < 8; ++ww) gm = fmaxf(gm, WMX3[ww * 32 + r]);
      float gl = 0.f;
#pragma unroll
      for (int ww = 0; ww < 8; ++ww) gl += WSM3[ww * 32 + r] * ex2(WMX3[ww * 32 + r] - gm);
      const float f = gl > 0.f ? gt[32 + head] * ex2(S.mrun - gm) / gl : 0.f;
#pragma unroll
      for (int dt = 0; dt < 2; ++dt)
#pragma unroll
          for (int reg = 0; reg < 16; ++reg) tot[dt][reg] += f * S.o[dt][reg]; }
    { LAS float* PART = (LAS float*)WK + 4 * h * 32 + r;
#pragma unroll
      for (int dt = 0; dt < 2; ++dt)
#pragma unroll
          for (int reg = 0; reg < 16; ++reg) PART[(32 * dt + (reg & 3) + 8 * (reg >> 2)) * 32] = tot[dt][reg]; }
    __syncthreads();
    { int tid = F.tid(); asm volatile("" : "+v"(tid)); const int col = tid >> 4, d0 = (tid & 15) * 4; f32x4 a = {0.f, 0.f, 0.f, 0.f};
#pragma unroll
      for (int ww = 0; ww < 8; ++ww) { const LAS float* P = (const LAS float*)(L + ww * AT_BUF);
#pragma unroll
          for (int e = 0; e < 4; ++e) a[e] += P[(d0 + e) * 32 + col]; }
      *(u32x2*)(w.G16 + (size_t)(RP + b * LS + (col >> 2)) * D + (kvh * 4 + (col & 3)) * 64 + d0) = pkh4(a); }
    __syncthreads();
}

#undef ATS_LOADQ
constexpr int CW_ATTQ = 512;
__device__ __forceinline__ void attn_phase(const Frame& F, const Args& args, int pass) {
    volatile LAS int* slot = (volatile LAS int*)(F.lds + LDS_MISC + 64);
    constexpr int NU = BS * KVH + BP * KVH * 32;
    for (;;) {
        if (F.tid() == 0) slot[0] = (int)__hip_atomic_fetch_add(args.w.ctl + CW_ATTQ + 64 * pass, 1u, __ATOMIC_RELAXED, __HIP_MEMORY_SCOPE_AGENT);
        __syncthreads();
        const int u = slot[0];
        __syncthreads();
        if (u >= NU) break;
        if (u < BS * KVH) attn_sample_unit(F, args, u >> 2, u & 3);
        else { const int v = u - BS * KVH; attn_prompt_unit(F, args, (v & 31) >> 2, v & 3, 31 - (v >> 5)); }
    }
}
constexpr int NPHASE = 19;
constexpr int CW_BAR = 1024;
__global__ void __launch_bounds__(NT, 2) mega(Args args) {
    extern __shared__ __attribute__((aligned(16))) unsigned char lds_raw[];
    Frame F; F.lds = (LAS unsigned char*)lds_raw; F.wave = __builtin_amdgcn_readfirstlane(threadIdx.x >> 6); F.G = gridDim.x; F.bid = blockIdx.x;
    const MW& w = args.w;
    volatile LAS unsigned* MISC = (volatile LAS unsigned*)(F.lds + LDS_MISC);
    if (F.tid() < 64) MISC[F.tid()] = 0u;
    __syncthreads();
    const int lo = args.ph_lo, hi = args.ph_hi;
    XcdBarrier bar; bar.bar = w.ctl + CW_BAR; bar.x = 0; bar.st = nullptr;
    if (hi - lo > 1) bar = xcd_barrier_post(w.ctl + CW_BAR, MISC + 8, F.wave);
    constexpr int pass = 0;
#ifndef PHASE_MASK
#define PHASE_MASK 0xFFFFFFFFu
#endif
#define IN(k) (((PHASE_MASK >> (k)) & 1u) && lo <= (k) && (k) < hi)
#define SEAM(k) do { if (IN(k) && IN((k) + 1)) xcd_barrier(bar, F.wave); } while (0)
    float* X = w.out + O_Y;
    const float* MOD = w.MOD;

    if (IN(0)) { p0_prep(F, args); } SEAM(0);
    if (IN(1)) { RowPass P{}; P.xa = INP(0); P.xb = INP(1); P.w1 = INP(10); P.sh1 = 0; P.H1 = w.H16; row_pass<F_H1, 0>(F, MOD, P); } SEAM(1);
    if (IN(2)) { s5_phase(F, args); } SEAM(2);
    if (IN(3)) { { pg8::StaticOrder S; S.init(RP, D, F.G, F.bid); pg8::PlainLay L{w.G16, w.Wglu, D}; EpiGlu E{w.G16, INP(23), w.OUTH}; pg8::gemm_phase(F.lds, F.wave, D, S, L, E); }
                 { int wv2 = F.wave; asm volatile("" : "+s"(wv2)); pg8::SplitOrder S{F.G, F.bid, 16}; pg8::SplitLay L{w.G16 + (size_t)RP * D, w.Wglu, D}; EpiPart E{w.PART}; pg8::gemm_phase(F.lds, wv2, 256, S, L, E); } } SEAM(3);
    if (IN(4)) { RowPass P{}; P.xa = INP(0); P.xb = INP(1); P.O = w.OUTH; P.part = w.PART; P.nsplit = 4; P.glu_g = w.G16; P.glu_b = INP(23); P.wpost = INP(11); P.gate_off = 2048; P.XHout = w.XH; P.w1 = INP(10) + D; P.sh1 = 3072; P.H1 = w.H16; row_pass<F_O | F_PART | F_GLU | F_XHOUT | F_H1, 4>(F, MOD, P); } SEAM(4);
    if (IN(5)) { pg8::StaticOrder S; S.init(R, F2, F.G, F.bid); pg8::PlainLay L{w.H16, w.Wup0, D}; EpiUp E{w.UP16, w.out + O_CONV_P, w.out + O_CONV_S}; pg8::gemm_phase(F.lds, F.wave, D, S, L, E); } SEAM(5);
    if (IN(6)) { conv_phase(F, args, 0); } SEAM(6);
    if (IN(7)) { { pg8::StaticOrder S; S.init(RP, D, F.G, F.bid); pg8::PlainLay L{w.ACT16, w.Wdn0, FF}; EpiH16 E{w.OUTH, D}; pg8::gemm_phase(F.lds, F.wave, FF, S, L, E); }
                 { int wv2 = F.wave; asm volatile("" : "+s"(wv2)); pg8::SplitOrder S{F.G, F.bid, 44}; pg8::SplitLay L{w.ACT16 + (size_t)RP * FF, w.Wdn0, FF}; EpiPart E{w.PART}; pg8::gemm_phase(F.lds, wv2, 256, S, L, E); } } SEAM(7);
    if (IN(8)) { RowPass P{}; P.xh = w.XH; P.XHout = w.XH; P.O = w.OUTH; P.part = w.PART; P.nsplit = 11; P.wpost = INP(11) + D; P.gate_off = 3072 + 2048;
                 P.w1 = INP(28); P.sh1 = 12288; P.H1 = w.HKV16; P.w2 = INP(10) + 2 * D; P.sh2 = 6144; P.H2 = w.H16; row_pass<F_XH | F_XHOUT | F_O | F_PART | F_H1 | F_H2, 11>(F, MOD, P); } SEAM(8);
    if (IN(9)) { KvQgOrder S; S.init(F.G, F.bid); KvQgLay L{w.HKV16, w.Wkv, w.H16, w.Wqg}; EpiKvQg E{w.ROPE, w.KV16, w.CMPP, w.out, w.QP16, w.QR16, w.GATE}; pg8::gemm_phase(F.lds, F.wave, D, S, L, E); } SEAM(9);
    if (IN(10)) { { CmpOrderS S{F.G, F.bid}; CmpLayS L{w.CMP16, w.Wc1k, w.Wc1v}; EpiCmpS E{w.PBs16}; pg8::gemm_phase(F.lds, F.wave, 1024, S, L, E); }
                  { int wv2 = F.wave; asm volatile("" : "+s"(wv2)); CmpOrderP S{F.G, F.bid}; CmpLayP L{w.CMPP, w.Wc1k, w.Wc1v}; EpiCmpP E{w.PBp}; pg8::gemm_phase(F.lds, wv2, 256, S, L, E); } } SEAM(10);
    if (IN(11)) { cmp2_phase(F, args); } SEAM(11);
    if (IN(12)) { attn_phase(F, args, pass); } SEAM(12);
    if (IN(13)) { { pg8::StaticOrder S; S.init(RP, D, F.G, F.bid); pg8::PlainLay L{w.G16, w.Wo, D}; EpiH16 E{w.OUTH, D}; pg8::gemm_phase(F.lds, F.wave, D, S, L, E); }
                  { int wv2 = F.wave; asm volatile("" : "+s"(wv2)); pg8::SplitOrder S{F.G, F.bid, 16}; pg8::SplitLay L{w.G16 + (size_t)RP * D, w.Wo, D}; EpiPart E{w.PART}; pg8::gemm_phase(F.lds, wv2, 256, S, L, E); } } SEAM(13);
    if (IN(14)) { RowPass P{}; P.xh = w.XH; P.XHout = w.XH; P.O = w.OUTH; P.part = w.PART; P.nsplit = 4; P.wpost = INP(11) + 2 * D; P.gate_off = 6144 + 2048; P.w1 = INP(10) + 3 * D; P.sh1 = 9216; P.H1 = w.H16; row_pass<F_XH | F_XHOUT | F_O | F_PART | F_H1, 4>(F, MOD, P); } SEAM(14);
    if (IN(15)) { pg8::StaticOrder S; S.init(R, F2, F.G, F.bid); pg8::PlainLay L{w.H16, w.Wup1, D}; EpiUp E{w.UP16, w.out + O_CONV_P + (size_t)BP * 2 * F2, w.out + O_CONV_S + (size_t)BS * 2 * F2}; pg8::gemm_phase(F.lds, F.wave, D, S, L, E); } SEAM(15);
    if (IN(16)) { conv_phase(F, args, 1); } SEAM(16);
    if (IN(17)) { { pg8::StaticOrder S; S.init(RP, D, F.G, F.bid); pg8::PlainLay L{w.ACT16, w.Wdn1, FF}; EpiH16 E{w.OUTH, D}; pg8::gemm_phase(F.lds, F.wave, FF, S, L, E); }
                  { int wv2 = F.wave; asm volatile("" : "+s"(wv2)); pg8::SplitOrder S{F.G, F.bid, 44}; pg8::SplitLay L{w.ACT16 + (size_t)RP * FF, w.Wdn1, FF}; EpiPart E{w.PART}; pg8::gemm_phase(F.lds, wv2, 256, S, L, E); } } SEAM(17);
    if (IN(18)) { RowPass P{}; P.xh = w.XH; P.O = w.OUTH; P.part = w.PART; P.nsplit = 11; P.wpost = INP(11) + 3 * D; P.gate_off = 9216 + 2048; P.Xout = X; row_pass<F_XH | F_O | F_PART | F_XOUT, 11>(F, MOD, P); }


#undef IN
#undef SEAM
}
#undef INP
}
extern "C" void kernel_launch(void* const* d_in, const int* in_sizes, int n_in, void* d_out, int out_size, void* d_ws, size_t ws_size, hipStream_t stream) {
    using namespace cfg;
    if (n_in != 38 || out_size != (int)O_END) { fprintf(stderr, "kernel_launch: unexpected problem shape (n_in %d, out %d)\n", n_in, out_size); return; }
    char* ws = (char*)d_ws; size_t off = 0;
    auto carve = [&](size_t bytes) { char* p = ws + off; off += (bytes + 255) & ~(size_t)255; return p; };
    mk::Args a{};
    for (int i = 0; i < 38; ++i) a.in[i] = d_in[i];
    mk::MW& w = a.w;
    w.ctl = (unsigned*)carve(1 << 20);
    w.MOD = (float*)carve((size_t)NSEQ * MODW * 4); w.ROPE = (float2*)carve((size_t)NROPE * 32 * 8); w.CB = (float*)carve(256 * 4);
    w.Wglu = (mk::h16*)carve((size_t)D * D * 2); w.Wup0 = (mk::h16*)carve((size_t)F2 * D * 2); w.Wup1 = (mk::h16*)carve((size_t)F2 * D * 2);
    w.Wdn0 = (mk::h16*)carve((size_t)D * FF * 2); w.Wdn1 = (mk::h16*)carve((size_t)D * FF * 2); w.Wkv = (mk::h16*)carve((size_t)NKV * D * 2);
    w.Wqg = (mk::h16*)carve((size_t)1280 * D * 2); w.Wo = (mk::h16*)carve((size_t)D * D * 2); w.Wc1k = (mk::h16*)carve((size_t)256 * 1024 * 2); w.Wc1v = (mk::h16*)carve((size_t)256 * 1024 * 2);
    w.H16 = (mk::h16*)carve((size_t)(R + 64) * D * 2); w.G16 = (mk::h16*)carve((size_t)R * D * 2); w.UP16 = (mk::h16*)carve((size_t)R * F2 * 2); w.ACT16 = (mk::h16*)carve((size_t)R * FF * 2);
    w.HKV16 = (mk::h16*)carve((size_t)R * D * 2); w.KV16 = (mk::h16*)carve((size_t)R * 1024 * 2); w.CMPP = (mk::h16*)carve((size_t)RP * 512 * 2); w.QP16 = (mk::h16*)carve((size_t)R * D * 2); w.QR16 = (mk::h16*)carve((size_t)R * D * 2);
    w.CMP16 = (mk::h16*)carve((size_t)BS * PAST * 512 * 2);
    w.KC16p = (mk::h16*)carve((size_t)BP * 128 * 256 * 2); w.VC16p = (mk::h16*)carve((size_t)BP * 128 * 256 * 2); w.KC16s = (mk::h16*)carve((size_t)BS * 512 * 256 * 2); w.VC16s = (mk::h16*)carve((size_t)BS * 512 * 256 * 2);
    w.OUTF = (float*)carve(256); w.OUTH = (mk::h16*)carve((size_t)R * D * 2); w.GATE = (float*)carve((size_t)R * 48 * 4); w.PBp = (float*)carve((size_t)4 * 2 * 4096 * 256 * 4); w.PBs = (float*)carve(256); w.XH = (mk::h16*)carve((size_t)R * D * 2); w.PBs16 = (mk::h16*)carve((size_t)2 * 65536 * 256 * 2); w.PART = (float*)carve((size_t)11 * 256 * 1024 * 4);
    w.out = (float*)d_out;
    if (off > ws_size) { fprintf(stderr, "kernel_launch: workspace too small (%zu > %zu)\n", off, ws_size); return; }
    static int grid = 0;
    if (!grid) {
        int dev = 0, cus = 0, per_cu = 0;
        if (hipGetDevice(&dev) != hipSuccess || hipDeviceGetAttribute(&cus, hipDeviceAttributeMultiprocessorCount, dev) != hipSuccess) cus = 256;
        if (hipFuncSetAttribute((const void*)mk::mega, hipFuncAttributeMaxDynamicSharedMemorySize, mk::LDS_BYTES) != hipSuccess) fprintf(stderr, "kernel_launch: hipFuncSetAttribute failed\n");
        if (hipOccupancyMaxActiveBlocksPerMultiprocessor(&per_cu, (const void*)mk::mega, mk::NT, mk::LDS_BYTES) != hipSuccess || per_cu < 1)
            fprintf(stderr, "kernel_launch: occupancy query reports %d workgroups per CU\n", per_cu);
        (void)hipGetLastError();
        grid = cus > 0 ? cus : 256;
    }
    if (hipMemsetAsync(w.ctl, 0, 1 << 20, stream) != hipSuccess) { fprintf(stderr, "kernel_launch: memset failed\n"); return; }
    a.ph_lo = 0; a.ph_hi = mk::NPHASE;
    hipLaunchKernelGGL(mk::mega, dim3(grid), dim3(mk::NT), mk::LDS_BYTES, stream, a);
}
```

```cpp
#include <hip/hip_runtime.h>
#include <stdint.h>
#include <stdio.h>
#include <math.h>

namespace cfg {
constexpr int D = 1024, BP = 8, LP = 2048, BS = 32, LS = 8, RP = BP * LP, RS = BS * LS, R = RP + RS, NSEQ = BP + BS;
constexpr int PAST = 8192, PAGE = 128, NPAGES = 64;
constexpr int G = 64, P = 64;
constexpr int NH = 16, HD = 64, KVH = 4;
constexpr int FF = 2816, F2 = 5632;
constexpr int NQG = 1072, NKV = 1536;
constexpr int WIN = 512;
constexpr int NC_P = 127, NC_S = 511, NS_P = 32, NS_S = 129, NSEL = 16;
constexpr int MODW = 4 * 3072 + 2048;
constexpr int NROPE = LP + LS;
constexpr float EPS = 1e-6f, NEG = -1e30f;
constexpr size_t O_Y = 0, O_ROWS = (size_t)R * 1024, O_WIN_P = O_ROWS + (size_t)R * 1024, O_WIN_S = O_WIN_P + (size_t)BP * WIN * 512,
                 O_SRE_P = O_WIN_S + (size_t)RS * 512, O_SIM_P = O_SRE_P + BP * G * P, O_SRE_S = O_SIM_P + BP * G * P, O_SIM_S = O_SRE_S + BS * G * P,
                 O_CONV_P = O_SIM_S + BS * G * P, O_CONV_S = O_CONV_P + (size_t)2 * BP * 2 * F2, O_END = O_CONV_S + (size_t)2 * BS * 2 * F2;
static_assert(O_END == 37535744, "output size");
__host__ __device__ __forceinline__ int modrow(int row) { return row < RP ? (row >> 11) : BP + ((row - RP) >> 3); }
__host__ __device__ __forceinline__ int ropeidx(int row) { return row < RP ? (row & (LP - 1)) : LP + ((row - RP) & 7); }
}
namespace mk {
using namespace cfg;
#define LAS __attribute__((address_space(3)))
#define GAS __attribute__((address_space(1)))
typedef _Float16 h16;
typedef _Float16 h2v __attribute__((ext_vector_type(2)));
typedef _Float16 h4v __attribute__((ext_vector_type(4)));
typedef _Float16 h8v __attribute__((ext_vector_type(8)));
typedef float f32x2 __attribute__((ext_vector_type(2)));
typedef float f32x4 __attribute__((ext_vector_type(4)));
typedef float f32x16 __attribute__((ext_vector_type(16)));
typedef unsigned u32x2 __attribute__((ext_vector_type(2)));
typedef unsigned u32x4 __attribute__((ext_vector_type(4)));
typedef short s16x4 __attribute__((ext_vector_type(4)));
constexpr int NT = 512, NW = 8;
constexpr int LDS_BYTES = 147456;
constexpr int LDS_MISC = LDS_BYTES - 256;

__device__ __forceinline__ int lane_id() { int l; asm volatile("v_mbcnt_lo_u32_b32 %0, -1, 0\n\tv_mbcnt_hi_u32_b32 %0, -1, %0" : "=v"(l)); return l; }
__device__ __forceinline__ float wsum(float v) {
#pragma unroll
    for (int o = 32; o >= 1; o >>= 1) v += __shfl_xor(v, o);
    return v;
}
__device__ __forceinline__ float wmaxf(float v) {
#pragma unroll
    for (int o = 32; o >= 1; o >>= 1) v = fmaxf(v, __shfl_xor(v, o));
    return v;
}
__device__ __forceinline__ float fexp(float x) { return __builtin_amdgcn_exp2f(x * 1.4426950408889634f); }
__device__ __forceinline__ float sigm(float x) { return __builtin_amdgcn_rcpf(1.f + fexp(-x)); }
__device__ __forceinline__ float silu(float x) { return x * sigm(x); }
__device__ __forceinline__ float gelu_t(float x) { const float u = 0.7978845608028654f * (x + 0.044715f * x * x * x); return x * sigm(2.f * u); }
__device__ __forceinline__ unsigned pkh(float a, float b) { h2v v; v.x = (h16)a; v.y = (h16)b; return __builtin_bit_cast(unsigned, v); }
__device__ __forceinline__ u32x2 pkh4(f32x4 v) { u32x2 r; r.x = pkh(v[0], v[1]); r.y = pkh(v[2], v[3]); return r; }

#define XB_TMO      128
#define XB_XCNT(j)  (256  + 64 * (j))
#define XB_XSUB(j)  (1280 + 64 * (j))
#define XB_XGEN(j)  (2304 + 64 * (j))
#define XB_TOP      3328
#define XB_TOPGEN   3392
#define XCD_BAR_WORDS 3456
#define XB_SPIN_CAP (1u << 18)
__device__ __forceinline__ unsigned xb_ld(unsigned* p)              { return __hip_atomic_load(p, __ATOMIC_RELAXED, __HIP_MEMORY_SCOPE_AGENT); }
__device__ __forceinline__ unsigned xb_add(unsigned* p, unsigned v) { return __hip_atomic_fetch_add(p, v, __ATOMIC_RELAXED, __HIP_MEMORY_SCOPE_AGENT); }
__device__ __forceinline__ unsigned xb_xcc_id() { return (unsigned)__builtin_amdgcn_s_getreg((3 << 11) | 20) & 0xFu; }
#define XB_SPIN(cond, bar) do { unsigned _sp = 0; while (cond) { __builtin_amdgcn_s_sleep(1); \
    if ((++_sp & 255u) == 0u) { if (xb_ld(&(bar)[XB_TMO])) break; if (_sp > XB_SPIN_CAP) { atomicAdd(&(bar)[XB_TMO], 1u); break; } } } } while (0)
struct XcdBarrier { unsigned* bar; unsigned x; volatile LAS unsigned* st; };
__device__ __forceinline__ XcdBarrier xcd_barrier_post(unsigned* bar, volatile LAS unsigned* st, int wave) {
    XcdBarrier b; b.bar = bar; b.x = xb_xcc_id(); b.st = st;
    if (wave == 0 && lane_id() == 0) (void)xb_add(&bar[XB_XCNT(b.x)], 1u);
    return b;
}
__device__ __forceinline__ void xcd_barrier_complete(unsigned* bar, unsigned x, unsigned& nloc, unsigned& nx) {
    const unsigned G = gridDim.x * gridDim.y * gridDim.z;
    unsigned sum, cnt, mine, sp = 0u;
    for (;;) {
        sum = 0u; cnt = 0u; mine = 0u;
#pragma unroll
        for (unsigned j = 0; j < 16; ++j) { const unsigned c = xb_ld(&bar[XB_XCNT(j)]); sum += c; cnt += (c > 0u) ? 1u : 0u; mine = (j == x) ? c : mine; }
        if (sum == G) break;
        __builtin_amdgcn_s_sleep(1);
        if ((++sp & 255u) == 0u) { if (xb_ld(&bar[XB_TMO])) break; if (sp > XB_SPIN_CAP) { atomicAdd(&bar[XB_TMO], 1u); break; } }
    }
    nloc = mine > 0u ? mine : 1u; nx = cnt > 0u ? cnt : 1u;
}
__device__ __forceinline__ void xcd_barrier(const XcdBarrier& b, int wave) {
    asm volatile("s_waitcnt vmcnt(0)" ::: "memory");
    __syncthreads();
    if (wave == 0 && lane_id() == 0) {
        unsigned* bar = b.bar;
        __builtin_amdgcn_s_waitcnt(0);
        unsigned nloc = b.st[0], nx = b.st[1];
        if (nloc == 0u) { xcd_barrier_complete(bar, b.x, nloc, nx); b.st[0] = nloc; b.st[1] = nx; }
        const unsigned old = xb_add(&bar[XB_XSUB(b.x)], 1u);
        const unsigned gen = old / nloc;
        if (old + 1u == (gen + 1u) * nloc) {
            __builtin_amdgcn_fence(__ATOMIC_RELEASE, "agent");
            asm volatile("s_waitcnt vmcnt(0)" ::: "memory");
            const unsigned og = xb_add(&bar[XB_TOP], 1u);
            const unsigned tg = og / nx;
            if (og + 1u == (tg + 1u) * nx) xb_add(&bar[XB_TOPGEN], 1u);
            else XB_SPIN(xb_ld(&bar[XB_TOPGEN]) == tg, bar);
            __builtin_amdgcn_fence(__ATOMIC_ACQUIRE, "agent");
            xb_add(&bar[XB_XGEN(b.x)], 1u);
            asm volatile("s_waitcnt vmcnt(0)" ::: "memory");
        } else {
            XB_SPIN(xb_ld(&bar[XB_XGEN(b.x)]) == gen, bar);
            __builtin_amdgcn_fence(__ATOMIC_ACQUIRE, "agent");
            asm volatile("s_waitcnt vmcnt(0)" ::: "memory");
        }
    }
    __syncthreads();
}

namespace pg8 {
constexpr int BM = 256, BK = 64, HALF = 128, HTB = HALF * BK * 2, STAGE_BYTES = 8 * HTB, NXCD = 8, WGM = 8;
__host__ __device__ __forceinline__ int lds_byte(int r, int c) { const int st = (r >> 4) * 2 + (c >> 5), rr = r & 15, cc = c & 31, ob = rr * 64 + cc * 2; return st * 1024 + (ob ^ (((ob >> 9) & 1) << 5)); }
__host__ __device__ __forceinline__ void stage_rc(int b, int& R_, int& C_) { const int st = b / 1024, sb = b % 1024, swz = sb ^ (((sb >> 9) & 1) << 5); R_ = (st >> 1) * 16 + swz / 64; C_ = (st & 1) * 32 + (swz % 64) / 2; }
__host__ __device__ __forceinline__ int perm32(int rho) { const int n = rho >> 4, i = rho & 15; return 8 * (i >> 2) + 4 * n + (i & 3); }
struct Unit { int pm, pn, sub; };
struct StaticOrder {
    int nM, nN, nwg, G, c;
    __device__ void init(int M, int N, int G_, int c_) { nM = M / BM; nN = N / BM; nwg = nM * nN; G = G_; c = c_; }
    __device__ bool next(int i, Unit& u) const {
        const long L = (long)i * G + c; if (L >= nwg) return false;
        int wgid = (int)L; { const int q = nwg / NXCD, r = nwg % NXCD, xcd = wgid % NXCD, off = wgid / NXCD; wgid = (xcd < r ? xcd * (q + 1) : r * (q + 1) + (xcd - r) * q) + off; }
        const int nig = WGM * nN, gid = wgid / nig, fm = gid * WGM, gsz = (nM - fm) < WGM ? (nM - fm) : WGM;
        u.pm = fm + ((wgid % nig) % gsz); u.pn = (wgid % nig) / gsz; u.sub = 0; return true;
    }
};
struct PlainLay {
    const h16* A; const h16* Bt; int K;
    __device__ __forceinline__ unsigned a_rowoff(int r) const { return (unsigned)r * (unsigned)K * 2u; }
    __device__ __forceinline__ unsigned b_rowoff(int r) const { return (unsigned)r * (unsigned)K * 2u; }
    __device__ __forceinline__ size_t a_kstep() const { return 128; }
    __device__ __forceinline__ const char* a_ptr(const Unit& u) const { return (const char*)A + (size_t)u.pm * 256 * K * 2; }
    __device__ __forceinline__ const char* b_ptr(const Unit& u) const { return (const char*)Bt + (size_t)u.pn * 256 * K * 2; }
};
struct SplitOrder { int G, c, n; __device__ bool next(int i, Unit& u) const { const int L = i * G + c; if (L >= n) return false; u.pm = 0; u.pn = L & 3; u.sub = L >> 2; return true; } };
struct SplitLay {
    const h16* A; const h16* Bt; int K;
    __device__ __forceinline__ unsigned a_rowoff(int r) const { return (unsigned)r * (unsigned)K * 2u; }
    __device__ __forceinline__ unsigned b_rowoff(int r) const { return (unsigned)r * (unsigned)K * 2u; }
    __device__ __forceinline__ size_t a_kstep() const { return 128; }
    __device__ __forceinline__ const char* a_ptr(const Unit& u) const { return (const char*)A + (size_t)u.sub * 512; }
    __device__ __forceinline__ const char* b_ptr(const Unit& u) const { return (const char*)Bt + (size_t)u.pn * 256 * K * 2 + (size_t)u.sub * 512; }
};

template <class Epi, class Sched, class Lay>
__device__ __forceinline__ void gemm_phase(LAS unsigned char* lds, const int wave, const int K, const Sched& S, const Lay& L, const Epi& E) {
    int tid = wave * 64 + lane_id(); asm volatile("" : "+v"(tid));
    const int wid = wave, lane = tid & 63, wr = wid >> 2, wc = wid & 3, fr = lane & 15, fq = lane >> 4;
    const int nt = K / BK;
    unsigned voffA[2], voffB[2];
#pragma unroll
    for (int i = 0; i < 2; ++i) { int R_, C_; stage_rc(tid * 16 + i * 8192, R_, C_); const int Rb = Epi::PERM ? ((R_ & ~31) + perm32(R_ & 31)) : R_;
        voffA[i] = L.a_rowoff(R_) + (unsigned)C_ * 2u; voffB[i] = L.b_rowoff(Rb) + (unsigned)C_ * 2u; }
    const size_t kstepA = L.a_kstep(), kstepB = (size_t)(BK * 2);
    const size_t hstepA = (size_t)L.a_rowoff(HALF), hstepB = (size_t)L.b_rowoff(HALF);
    const unsigned ldsw = (unsigned)wid * 1024u;
    const int aoff = lds_byte(wr * 64 + fr, fq * 8), boff = lds_byte(wc * 32 + fr, fq * 8);
#define PG8_SA(b, h) (((b) * 2 + (h)) * HTB)
#define PG8_SB(b, h) ((4 + (b) * 2 + (h)) * HTB)
#define PG8_STAGE(bufoff, gbase, voff) do { _Pragma("unroll") for (int _i = 0; _i < 2; ++_i) \
        __builtin_amdgcn_global_load_lds((const unsigned*)((const char*)(gbase) + (voff)[_i]), (LAS unsigned*)(lds + (bufoff) + ldsw + _i * 8192), 16, 0, 0); } while (0)
#define PG8_LDA(dst, b, h) do { _Pragma("unroll") for (int m = 0; m < 4; ++m) _Pragma("unroll") for (int k = 0; k < 2; ++k) dst[m][k] = *(const LAS h8v*)(lds + PG8_SA(b, h) + aoff + m * 2048 + k * 1024); } while (0)
#define PG8_LDB(dst, b, h) do { _Pragma("unroll") for (int n = 0; n < 2; ++n) _Pragma("unroll") for (int k = 0; k < 2; ++k) dst[n][k] = *(const LAS h8v*)(lds + PG8_SB(b, h) + boff + n * 2048 + k * 1024); } while (0)
#define PG8_MMA(ai, bj, At, Bt) do { __builtin_amdgcn_s_setprio(1); _Pragma("unroll") for (int m = 0; m < 4; ++m) _Pragma("unroll") for (int n = 0; n < 2; ++n) _Pragma("unroll") for (int k = 0; k < 2; ++k) \
        acc[ai][bj][m][n] = __builtin_amdgcn_mfma_f32_16x16x32_f16(Bt[n][k], At[m][k], acc[ai][bj][m][n], 0, 0, 0); __builtin_amdgcn_s_setprio(0); } while (0)
#define PG8_WAIT_V(n) asm volatile("s_waitcnt vmcnt(" #n ")" ::: "memory")
#define PG8_WAIT_L(n) asm volatile("s_waitcnt lgkmcnt(" #n ")" ::: "memory")
#define PG8_BAR __builtin_amdgcn_s_barrier()
#define PG8_SCHED __builtin_amdgcn_sched_barrier(0)
    Unit cur, nxt; int ui = 0;
    if (!S.next(0, cur)) return;
    f32x4 acc[2][2][4][2];
#pragma unroll
    for (int a = 0; a < 2; ++a)
#pragma unroll
        for (int b = 0; b < 2; ++b)
#pragma unroll
            for (int m = 0; m < 4; ++m)
#pragma unroll
                for (int n = 0; n < 2; ++n) acc[a][b][m][n] = (f32x4){0.f, 0.f, 0.f, 0.f};
    h8v At[4][2], B0[2][2], B1[2][2];
    const char* cA = L.a_ptr(cur); const char* cB = L.b_ptr(cur);
    PG8_STAGE(PG8_SB(0, 0), cB, voffB); PG8_STAGE(PG8_SB(0, 1), cB + hstepB, voffB); PG8_STAGE(PG8_SA(0, 0), cA, voffA); PG8_STAGE(PG8_SA(0, 1), cA + hstepA, voffA);
    if (wr == 1) PG8_BAR;
    PG8_WAIT_V(2); PG8_BAR;
    PG8_STAGE(PG8_SB(1, 0), cB + kstepB, voffB); PG8_STAGE(PG8_SA(1, 0), cA + kstepA, voffA); PG8_STAGE(PG8_SB(1, 1), cB + hstepB + kstepB, voffB);
    PG8_WAIT_V(6); PG8_BAR;
    for (;;) {
        const bool has_next = S.next(ui + 1, nxt);
        const char* nA = has_next ? L.a_ptr(nxt) : cA; const char* nB = has_next ? L.b_ptr(nxt) : cB;
#pragma unroll 1
        for (int t = 0; t < nt; t += 2) {
            const bool last = (t == nt - 2);
            const char* a1 = cA + (size_t)(t + 1) * kstepA;
            const char* a2 = last ? nA : cA + (size_t)(t + 2) * kstepA; const char* b2 = last ? nB : cB + (size_t)(t + 2) * kstepB;
            const char* a3 = a2 + kstepA; const char* b3 = b2 + kstepB;
            PG8_LDB(B0, 0, 0); PG8_LDB(B1, 0, 1); PG8_SCHED; PG8_LDA(At, 0, 0); PG8_STAGE(PG8_SA(1, 1), a1 + hstepA, voffA);
            PG8_WAIT_V(8); PG8_WAIT_L(0); PG8_BAR; PG8_MMA(0, 0, At, B0); PG8_MMA(0, 1, At, B1); PG8_BAR; PG8_SCHED;
            PG8_LDA(At, 0, 1); PG8_STAGE(PG8_SB(0, 0), b2, voffB); PG8_STAGE(PG8_SB(0, 1), b2 + hstepB, voffB); PG8_STAGE(PG8_SA(0, 0), a2, voffA);
            PG8_WAIT_V(8); PG8_WAIT_L(0); PG8_BAR; PG8_MMA(1, 0, At, B0); PG8_MMA(1, 1, At, B1); PG8_BAR; PG8_SCHED;
            PG8_LDB(B0, 1, 0); PG8_LDB(B1, 1, 1); PG8_SCHED; PG8_LDA(At, 1, 0); PG8_STAGE(PG8_SA(0, 1), a2 + hstepA, voffA);
            PG8_WAIT_V(8); PG8_WAIT_L(0); PG8_BAR; PG8_MMA(0, 0, At, B0); PG8_MMA(0, 1, At, B1); PG8_BAR; PG8_SCHED;
            PG8_LDA(At, 1, 1); PG8_STAGE(PG8_SB(1, 0), b3, voffB); PG8_STAGE(PG8_SB(1, 1), b3 + hstepB, voffB); PG8_STAGE(PG8_SA(1, 0), a3, voffA);
            PG8_WAIT_V(8); PG8_WAIT_L(0); PG8_BAR; PG8_MMA(1, 0, At, B0); PG8_MMA(1, 1, At, B1); PG8_BAR; PG8_SCHED;
        }
        if (wr == 0) PG8_BAR;
        { int fr2 = fr, fq2 = fq; asm volatile("" : "+v"(fr2), "+v"(fq2)); E(acc, cur, wr, wc, fr2, fq2); }
        if (!has_next) break;
#pragma unroll
        for (int a = 0; a < 2; ++a)
#pragma unroll
            for (int b = 0; b < 2; ++b)
#pragma unroll
                for (int m = 0; m < 4; ++m)
#pragma unroll
                    for (int n = 0; n < 2; ++n) acc[a][b][m][n] = (f32x4){0.f, 0.f, 0.f, 0.f};
        cur = nxt; cA = nA; cB = nB; ++ui;
        if (wr == 1) PG8_BAR;
    }
    PG8_WAIT_V(0);
    PG8_BAR;
#undef PG8_SA
#undef PG8_SB
#undef PG8_STAGE
#undef PG8_LDA
#undef PG8_LDB
#undef PG8_MMA
#undef PG8_WAIT_V
#undef PG8_WAIT_L
#undef PG8_BAR
#undef PG8_SCHED
}
}
struct MW {
    unsigned* ctl; float* MOD; float2* ROPE; float* CB;
    h16 *Wglu, *Wup0, *Wup1, *Wdn0, *Wdn1, *Wkv, *Wqg, *Wo, *Wc1k, *Wc1v;
    h16 *XH, *PBs16, *OUTH, *H16, *G16, *UP16, *ACT16, *HKV16, *KV16, *CMPP, *QP16, *QR16, *CMP16, *KC16p, *VC16p, *KC16s, *VC16s;
    float *OUTF, *GATE, *PBp, *PBs, *PART;
    float* out;
};
struct Args { const void* in[38]; MW w; int ph_lo, ph_hi; };
static_assert(sizeof(Args) % 8 == 0, "Args has no tail padding");

struct Frame {
    LAS unsigned char* lds; int wave, G, bid;
    __device__ __forceinline__ int lane() const { return lane_id(); }
    __device__ __forceinline__ int tid() const { return wave * 64 + lane_id(); }
};
#define INP(i) ((const float*)args.in[i])

constexpr int S5_BU = 128 * 144, S5_RS = 80, S5_WAVE_LDS = S5_BU + 128 * S5_RS;
__device__ __forceinline__ int colmap(int map, int n) {
    if (map == 0) return n;
    if (map == 1) { const int hb = n >> 6, j = n & 63; return hb * 64 + 4 * (j >> 3) + (j & 3) + 32 * ((j >> 2) & 1); }
      if (n < 1024) { const int hb = n >> 6, j = n & 63; return hb * 64 + 4 * (j >> 3) + (j & 3) + 32 * ((j >> 2) & 1); }
    return n < NQG ? n : -1;
}
__device__ __forceinline__ void tr_item(const float* W, int ldw, int K, h16* WT, int nblk, int map, int item, int lane) {
    const int kb = item / nblk, nb = item % nblk, n0 = 32 * nb, nl = lane & 31, kh = lane >> 5;
    const int nsrc = colmap(map, n0 + nl);
    const float* src = W + (size_t)(64 * kb + 32 * kh) * ldw + (nsrc >= 0 ? nsrc : 0);
    float v[32];
#pragma unroll
    for (int i = 0; i < 32; ++i) v[i] = src[(size_t)i * ldw];
    h16* dst = WT + (size_t)(n0 + nl) * K + 64 * kb + 32 * kh;
#pragma unroll
    for (int c = 0; c < 4; ++c) { u32x4 o;
        if (nsrc >= 0) { o.x = pkh(v[8 * c], v[8 * c + 1]); o.y = pkh(v[8 * c + 2], v[8 * c + 3]); o.z = pkh(v[8 * c + 4], v[8 * c + 5]); o.w = pkh(v[8 * c + 6], v[8 * c + 7]); } else o = (u32x4){0u, 0u, 0u, 0u};
        *(u32x4*)(dst + 8 * c) = o; }
}
__device__ __forceinline__ void sincos_d(double x, double& s, double& c) {
    const double k = rint(x * 0.63661977236758134308);
    double r = fma(-k, 1.57079632679489655800e+00, x);
    r = fma(-k, 6.12323399573676603587e-17, r);
    const double r2 = r * r;
    double ps = -1.0 / 1307674368000.0;
    ps = fma(ps, r2, 1.0 / 6227020800.0); ps = fma(ps, r2, -1.0 / 39916800.0); ps = fma(ps, r2, 1.0 / 362880.0); ps = fma(ps, r2, -1.0 / 5040.0);
    ps = fma(ps, r2, 1.0 / 120.0); ps = fma(ps, r2, -1.0 / 6.0); ps = fma(ps, r2, 1.0);
    const double sr = ps * r;
    double pc = 1.0 / 20922789888000.0;
    pc = fma(pc, r2, -1.0 / 87178291200.0); pc = fma(pc, r2, 1.0 / 479001600.0); pc = fma(pc, r2, -1.0 / 3628800.0); pc = fma(pc, r2, 1.0 / 40320.0);
    pc = fma(pc, r2, -1.0 / 720.0); pc = fma(pc, r2, 1.0 / 24.0); pc = fma(pc, r2, -0.5);
    const double cr = fma(pc, r2, 1.0);
    const int q = ((int)k) & 3;
    s = (q == 0) ? sr : (q == 1) ? cr : (q == 2) ? -sr : -cr;
    c = (q == 0) ? cr : (q == 1) ? -sr : (q == 2) ? -cr : sr;
}

__device__ __forceinline__ void adaln_item(const Frame& F, const Args& args, int item) {
    const int l = F.lane(), r = l & 31, h = l >> 5, cg = F.wave >> 2, kq = F.wave & 3;
    const int col0 = item * 64 + cg * 32;
    const float* W; int ld;
    if (col0 < 12288) { const int m = col0 / 3072; W = INP(12) + (size_t)m * D * 3072 + (col0 - m * 3072); ld = 3072; } else { W = INP(29) + (col0 - 12288); ld = 2048; }
    const float* c0 = r < BP ? INP(8) + r * D : INP(9) + (r - BP) * D;
    const float* c1 = INP(9) + (24 + (r & 7)) * D;
    f32x16 acc0 = {0.f, 0.f, 0.f, 0.f, 0.f, 0.f, 0.f, 0.f, 0.f, 0.f, 0.f, 0.f, 0.f, 0.f, 0.f, 0.f}, acc1 = acc0;
    for (int ks = 0; ks < 16; ks += 2) {
        float wv[2][8]; f32x4 ca[2][2], cb[2][2];
#pragma unroll
        for (int u = 0; u < 2; ++u) { const int k0 = 256 * kq + 16 * (ks + u) + 8 * h;
#pragma unroll
            for (int j = 0; j < 8; ++j) wv[u][j] = W[(size_t)(k0 + j) * ld + r];
            ca[u][0] = *(const f32x4*)(c0 + k0); ca[u][1] = *(const f32x4*)(c0 + k0 + 4); cb[u][0] = *(const f32x4*)(c1 + k0); cb[u][1] = *(const f32x4*)(c1 + k0 + 4); }
#pragma unroll
        for (int u = 0; u < 2; ++u) { h8v a0, a1, bf;
#pragma unroll
            for (int j = 0; j < 8; ++j) { const float x0 = ca[u][j >> 2][j & 3], x1 = cb[u][j >> 2][j & 3]; a0[j] = (h16)silu(x0); a1[j] = (h16)(r < 8 ? silu(x1) : 0.f); bf[j] = (h16)wv[u][j]; }
            acc0 = __builtin_amdgcn_mfma_f32_32x32x16_f16(a0, bf, acc0, 0, 0, 0); acc1 = __builtin_amdgcn_mfma_f32_32x32x16_f16(a1, bf, acc1, 0, 0, 0); }
    }
    LAS float* red = (LAS float*)F.lds + (cg * 4 + kq) * 1280;
#pragma unroll
    for (int reg = 0; reg < 16; ++reg) red[((reg & 3) + 8 * (reg >> 2) + 4 * h) * 32 + r] = acc0[reg];
#pragma unroll
    for (int reg = 0; reg < 4; ++reg) red[(32 + reg + 4 * h) * 32 + r] = acc1[reg];
    __syncthreads();
    for (int o = F.tid(); o < 2 * 1280; o += NT) { const int g2 = o / 1280, rc = o % 1280, row = rc >> 5, cc = rc & 31; const LAS float* q = (const LAS float*)F.lds + g2 * 4 * 1280 + rc;
        const float sum = (q[0] + q[1280]) + (q[2560] + q[3840]); const int c2 = item * 64 + g2 * 32 + cc;
        args.w.MOD[(size_t)row * MODW + c2] = sum + (c2 < 12288 ? INP(13)[c2] : INP(30)[c2 - 12288]); }
    __syncthreads();
}

__device__ __forceinline__ void p0_prep(const Frame& F, const Args& args) {
    const MW& w = args.w;
    if (F.bid < MODW / 64) adaln_item(F, args, F.bid);
    for (int id = F.bid * NT + F.tid(); id < NROPE * 32; id += F.G * NT) {
        const int idx = id >> 5, i = id & 31;
        const double pos = idx < LP ? (double)idx : (double)(PAST + idx - LP);
        double f = 1.0; for (int j = 0; j < i; ++j) f *= 0.74989420933245582730;
        double s, c; sincos_d(pos * f, s, c);
        w.ROPE[id] = make_float2((float)c, (float)s);
    }
    for (int o = F.bid; o < 256; o += F.G) {
        const int slot = o >> 7, h = o & 127; const float* pe = INP(32) + slot * 2048; const float* w1 = INP(33) + (size_t)slot * 2048 * 128 + h;
        float a = 0.f;
#pragma unroll
        for (int i = 0; i < 4; ++i) { const int k = F.tid() + NT * i; a += pe[k] * w1[(size_t)k * 128]; }
        a = wsum(a);
        LAS float* red = (LAS float*)(F.lds + 131072);
        __syncthreads();
        if (F.lane() == 0) red[F.wave] = a;
        __syncthreads();
        if (F.tid() == 0) { float t = INP(34)[o]; for (int ww = 0; ww < NW; ++ww) t += red[ww]; w.CB[o] = t; }
    }
}

struct RowPass {
    const float* xa; const float* xb;
    const h16* xh; h16* XHout;
    const h16* O; const float* wpost; int gate_off;
    const float* part; int nsplit; const h16* glu_g; const float* glu_b;
    float* Xout;
    const float* w1; int sh1; h16* H1;
    const float* w2; int sh2; h16* H2;
};
struct RowData { f32x4 x[2][4]; h4v o[2][4]; };
constexpr int F_XH = 1, F_O = 2, F_PART = 4, F_GLU = 8, F_XOUT = 16, F_XHOUT = 32, F_H1 = 64, F_H2 = 128;
template <int FL, int NSPLIT, bool SAMPLE, int NR>
__device__ __forceinline__ void row_load(const RowPass& P, int row, int lane, RowData& d) {
    if (FL & F_XH) {
#pragma unroll
        for (int q = 0; q < NR; ++q)
#pragma unroll
            for (int j = 0; j < 4; ++j) { const h4v v = *(const h4v*)(P.xh + (size_t)(row + q) * D + 4 * lane + 256 * j); d.x[q][j] = (f32x4){(float)v[0], (float)v[1], (float)v[2], (float)v[3]}; }
    } else {
        const float* xr = row < RP ? P.xa + (size_t)row * D : P.xb + (size_t)(row - RP) * D;
#pragma unroll
        for (int q = 0; q < NR; ++q)
#pragma unroll
            for (int j = 0; j < 4; ++j) d.x[q][j] = *(const f32x4*)(xr + (size_t)q * D + 4 * lane + 256 * j);
    }
    if ((FL & F_O) && !(SAMPLE && (FL & F_PART))) {
#pragma unroll
        for (int q = 0; q < NR; ++q)
#pragma unroll
            for (int j = 0; j < 4; ++j) d.o[q][j] = *(const h4v*)(P.O + (size_t)(row + q) * D + 4 * lane + 256 * j);
    }
}
template <int FL, int NSPLIT, bool SAMPLE, int NR>
__device__ __forceinline__ void row_body(const RowPass& P, const float* MOD, const int row, const int lane, const RowData& cur) {
    const float* m = MOD + (size_t)modrow(row) * MODW;
    f32x4 wp[4], gt[4], nw[4], sh[4], sc[4];
#define ROW_PARAMS() _Pragma("unroll") for (int j = 0; j < 4; ++j) { const int c = 4 * lane + 256 * j; \
        if (FL & F_O) { wp[j] = *(const f32x4*)(P.wpost + c); gt[j] = *(const f32x4*)(m + P.gate_off + c); } \
        if (FL & F_H1) { nw[j] = *(const f32x4*)(P.w1 + c); sh[j] = *(const f32x4*)(m + P.sh1 + c); sc[j] = *(const f32x4*)(m + P.sh1 + 1024 + c); } }
    if (!(SAMPLE && (FL & F_PART))) { ROW_PARAMS() }
    f32x4 x[NR][4];
#pragma unroll
    for (int q = 0; q < NR; ++q)
#pragma unroll
        for (int j = 0; j < 4; ++j) x[q][j] = cur.x[q][j];
    if (FL & F_O) {
        f32x4 o[NR][4]; float ss[NR];
#pragma unroll
        for (int q = 0; q < NR; ++q) {
            ss[q] = 0.f;
            if (!(SAMPLE && (FL & F_PART))) {
#pragma unroll
                for (int j = 0; j < 4; ++j) { const h4v ov = cur.o[q][j]; o[q][j] = (f32x4){(float)ov[0], (float)ov[1], (float)ov[2], (float)ov[3]}; }
            } else {
#pragma unroll
                for (int j = 0; j < 4; ++j) o[q][j] = (f32x4){0.f, 0.f, 0.f, 0.f};
#pragma unroll 1
                for (int sp0 = 0; sp0 < NSPLIT; sp0 += 4) {
                    f32x4 t[4][4];
#pragma unroll
                    for (int u = 0; u < 4; ++u)
#pragma unroll
                        for (int j = 0; j < 4; ++j) { const int sp = sp0 + u < NSPLIT ? sp0 + u : 0; t[u][j] = *(const f32x4*)(P.part + ((size_t)sp * 256 + (row + q - RP)) * D + 4 * lane + 256 * j); }
#pragma unroll
                    for (int u = 0; u < 4; ++u)
#pragma unroll
                        for (int j = 0; j < 4; ++j) { const float k = sp0 + u < NSPLIT ? 1.f : 0.f; o[q][j] += t[u][j] * k; }
                }
                if (FL & F_GLU) {
#pragma unroll
                    for (int j = 0; j < 4; ++j) { const int c = 4 * lane + 256 * j; const h4v g = *(const h4v*)(P.glu_g + (size_t)(row + q) * D + c); const f32x4 bb = *(const f32x4*)(P.glu_b + c); f32x4 a = o[q][j];
                        a[0] = (float)g[0] * sigm(a[0] + bb[0]); a[1] = (float)g[1] * sigm(a[1] + bb[1]); a[2] = (float)g[2] * sigm(a[2] + bb[2]); a[3] = (float)g[3] * sigm(a[3] + bb[3]); o[q][j] = a; }
                }
            }
#pragma unroll
            for (int j = 0; j < 4; ++j) ss[q] += o[q][j][0] * o[q][j][0] + o[q][j][1] * o[q][j][1] + o[q][j][2] * o[q][j][2] + o[q][j][3] * o[q][j][3];
        }
        if (SAMPLE && (FL & F_PART)) { ROW_PARAMS() }
        float rr[NR];
#pragma unroll
        for (int q = 0; q < NR; ++q) rr[q] = rsqrtf(wsum(ss[q]) * (1.f / D) + EPS);
#pragma unroll
        for (int j = 0; j < 4; ++j)
#pragma unroll
            for (int q = 0; q < NR; ++q) x[q][j] += gt[j] * (o[q][j] * rr[q] * wp[j]);
    }
    if (FL & F_XOUT) {
#pragma unroll
        for (int q = 0; q < NR; ++q)
#pragma unroll
            for (int j = 0; j < 4; ++j) *(f32x4*)(P.Xout + (size_t)(row + q) * D + 4 * lane + 256 * j) = x[q][j];
    }
    if (FL & F_XHOUT) {
#pragma unroll
        for (int q = 0; q < NR; ++q)
#pragma unroll
            for (int j = 0; j < 4; ++j) *(u32x2*)(P.XHout + (size_t)(row + q) * D + 4 * lane + 256 * j) = pkh4(x[q][j]);
    }
    if (FL & F_H1) {
        float rr[NR];
#pragma unroll
        for (int q = 0; q < NR; ++q) { float ss = 0.f;
#pragma unroll
            for (int j = 0; j < 4; ++j) ss += x[q][j][0] * x[q][j][0] + x[q][j][1] * x[q][j][1] + x[q][j][2] * x[q][j][2] + x[q][j][3] * x[q][j][3];
            rr[q] = rsqrtf(wsum(ss) * (1.f / D) + EPS); }
#pragma unroll
        for (int j = 0; j < 4; ++j) { const int c = 4 * lane + 256 * j;
#pragma unroll
            for (int q = 0; q < NR; ++q) *(u32x2*)(P.H1 + (size_t)(row + q) * D + c) = pkh4(x[q][j] * rr[q] * nw[j] * (1.f + sc[j]) + sh[j]); }
        if (FL & F_H2) {
#pragma unroll
            for (int j = 0; j < 4; ++j) { const int c = 4 * lane + 256 * j; nw[j] = *(const f32x4*)(P.w2 + c); sh[j] = *(const f32x4*)(m + P.sh2 + c); sc[j] = *(const f32x4*)(m + P.sh2 + 1024 + c); }
#pragma unroll
            for (int j = 0; j < 4; ++j) { const int c = 4 * lane + 256 * j;
#pragma unroll
                for (int q = 0; q < NR; ++q) *(u32x2*)(P.H2 + (size_t)(row + q) * D + c) = pkh4(x[q][j] * rr[q] * nw[j] * (1.f + sc[j]) + sh[j]); }
        }
    }
}
#undef ROW_PARAMS
template <int FL, int NSPLIT>
__device__ __forceinline__ void row_pass(const Frame& F, const float* MOD, const RowPass& P) {
    const int gw = F.bid * NW + F.wave, NGW = F.G * NW, lane = F.lane();
    if (FL & F_PART) {
        const int gs = (gw & 7) * (NGW >> 3) + (gw >> 3);
        for (int s = gs; s < RS; s += NGW) { RowData d; row_load<FL, NSPLIT, true, 1>(P, RP + s, lane, d); row_body<FL, NSPLIT, true, 1>(P, MOD, RP + s, lane, d); }
    }
    constexpr int NP = (FL & F_PART) ? RP / 2 : R / 2;
    RowData cur, nxt;
    row_load<FL, NSPLIT, false, 2>(P, 2 * (gw < NP ? gw : NP - 1), lane, cur);
#pragma unroll
    for (int q = 0; q < 2; ++q)
#pragma unroll
        for (int j = 0; j < 4; ++j) { asm volatile("" : "+v"(cur.x[q][j])); if (FL & F_O) asm volatile("" : "+v"(cur.o[q][j])); }
#pragma unroll 1
    for (int rp = gw; rp < NP; rp += NGW) {
        const int rn = rp + NGW < NP ? rp + NGW : NP - 1;
        row_load<FL, NSPLIT, false, 2>(P, 2 * rn, lane, nxt);
        row_body<FL, NSPLIT, false, 2>(P, MOD, 2 * rp, lane, cur);
        cur = nxt;
    }
}

constexpr int CW_BGQ = 640;
template <int MODE = 0>
__device__ __forceinline__ void bg_work(const Frame& F, const Args& args) {
    const MW& w = args.w; const float* cache = INP(2); const int* ptab = (const int*)args.in[7]; const int lane = F.lane();
    constexpr int I_GLU = 16 * 32, I_UP = 16 * 176, I_DN = 44 * 32, I_KV = 16 * 48, I_QG = 16 * 40, I_WO = 16 * 32, I_C1 = 16 * 4;
    constexpr int NITEMS = I_GLU + 2 * I_UP + 2 * I_DN + I_KV + I_QG + I_WO + 4 * I_C1, NCONV = BS * PAST / 8;
    constexpr int GRP = 8, NG_T = (NITEMS + GRP - 1) / GRP, NG_C = NCONV / GRP;
    for (int sgi = F.wave * F.G + F.bid;; sgi += 8 * F.G) {
        int gi = 0;
        if (MODE == 1) { gi = sgi; if (gi >= NG_T) break; }
        else { if (lane == 0) gi = (int)__hip_atomic_fetch_add(w.ctl + CW_BGQ, 1u, __ATOMIC_RELAXED, __HIP_MEMORY_SCOPE_AGENT);
               gi = __builtin_amdgcn_readfirstlane(gi);
               if (gi >= NG_T + NG_C) break;
               if (MODE == 2 && gi < NG_T) continue; }
      for (int sub = 0; sub < GRP; ++sub) {
        const int it = gi < NG_T ? gi * GRP + sub : NITEMS + (gi - NG_T) * GRP + sub;
        if (gi < NG_T && it >= NITEMS) break;
        if (it >= NITEMS) {
            const int rp0 = (it - NITEMS) * 8;
            f32x4 v0[8], v1[8];
#pragma unroll
            for (int q = 0; q < 8; ++q) { const int rp = rp0 + q, b = rp >> 13, pos = rp & (PAST - 1);
                const float* src = cache + ((size_t)ptab[b * NPAGES + (pos >> 7)] * PAGE + (pos & 127)) * 1024 + lane * 4; v0[q] = __builtin_nontemporal_load((const f32x4*)src); v1[q] = __builtin_nontemporal_load((const f32x4*)(src + 256)); }
#pragma unroll
            for (int q = 0; q < 8; ++q) { h16* dst = w.CMP16 + (size_t)(rp0 + q) * 512 + lane * 4;
                __builtin_nontemporal_store((u32x2){pkh(v0[q][0], v0[q][1]), pkh(v0[q][2], v0[q][3])}, (u32x2*)dst); __builtin_nontemporal_store((u32x2){pkh(v1[q][0], v1[q][1]), pkh(v1[q][2], v1[q][3])}, (u32x2*)(dst + 256)); }
            continue;
        }
        int r = it;
        if (r < I_GLU) { tr_item(INP(22), D, D, w.Wglu, 32, 0, r, lane); continue; } r -= I_GLU;
        if (r < I_UP) { tr_item(INP(24), F2, D, w.Wup0, 176, 0, r, lane); continue; } r -= I_UP;
        if (r < I_UP) { tr_item(INP(24) + (size_t)D * F2, F2, D, w.Wup1, 176, 0, r, lane); continue; } r -= I_UP;
        if (r < I_DN) { tr_item(INP(27), D, FF, w.Wdn0, 32, 0, r, lane); continue; } r -= I_DN;
        if (r < I_DN) { tr_item(INP(27) + (size_t)FF * D, D, FF, w.Wdn1, 32, 0, r, lane); continue; } r -= I_DN;
        if (r < I_KV) { tr_item(INP(31), NKV, D, w.Wkv, 48, 1, r, lane); continue; } r -= I_KV;
        if (r < I_QG) { tr_item(INP(36), NQG, D, w.Wqg, 40, 2, r, lane); continue; } r -= I_QG;
        if (r < I_WO) { tr_item(INP(37), D, D, w.Wo, 32, 0, r, lane); continue; } r -= I_WO;
        { const int q = r / I_C1, rr = r % I_C1, slot = q >> 1, half = q & 1;
          tr_item(INP(33) + (size_t)slot * 2048 * 128 + (size_t)half * 1024 * 128, 128, 1024, (slot ? w.Wc1v : w.Wc1k) + (size_t)half * 128 * 1024, 4, 0, rr, lane); }
      }
    }
}
__device__ __forceinline__ void s5_disc(const float* lam_re, const float* lam_im, int g, int p, double dt, float& are, float& aim, double& zre, double& zim) {
    const double lr = lam_re[g * P + p], li = lam_im[g * P + p];
    const double mag = exp(lr * dt); double sn, cs; sincos_d(li * dt, sn, cs);
    const double ar = mag * cs, ai = mag * sn, den = lr * lr + li * li;
    zre = ((ar - 1.0) * lr + ai * li) / den; zim = (ai * lr - (ar - 1.0) * li) / den; are = (float)ar; aim = (float)ai;
}
template <bool FULL>
__device__ __forceinline__ void s5_chunk(const h8v (&bf)[4], const h8v (&cf)[4], const f32x4 dsk, const float are, const float aim, float& sr, float& si,
                                         LAS float* BU, LAS unsigned char* S16, const h8v uf, const h4v hv0, const h4v hv1, const int nvalid, h16* gout, const int l) {
    const int r = l & 31, h = l >> 5, q4 = l >> 4, fr = l & 15;
    f32x16 acc[4];
#pragma unroll
    for (int nt = 0; nt < 4; ++nt) { const f32x16 z = {0.f, 0.f, 0.f, 0.f, 0.f, 0.f, 0.f, 0.f, 0.f, 0.f, 0.f, 0.f, 0.f, 0.f, 0.f, 0.f}; acc[nt] = __builtin_amdgcn_mfma_f32_32x32x16_f16(uf, bf[nt], z, 0, 0, 0); }
#pragma unroll
    for (int nt = 0; nt < 4; ++nt)
#pragma unroll
        for (int rg = 0; rg < 4; ++rg) *(LAS f32x4*)(BU + (32 * nt + r) * 36 + 8 * rg + 4 * h) = (f32x4){acc[nt][4 * rg], acc[nt][4 * rg + 1], acc[nt][4 * rg + 2], acc[nt][4 * rg + 3]};
    float xr[32], xi[32];
#pragma unroll
    for (int i = 0; i < 8; ++i) { const f32x4 a = *(const LAS f32x4*)(BU + l * 36 + 4 * i), b = *(const LAS f32x4*)(BU + (64 + l) * 36 + 4 * i);
        xr[4 * i] = a[0]; xr[4 * i + 1] = a[1]; xr[4 * i + 2] = a[2]; xr[4 * i + 3] = a[3]; xi[4 * i] = b[0]; xi[4 * i + 1] = b[1]; xi[4 * i + 2] = b[2]; xi[4 * i + 3] = b[3]; }
#pragma unroll
    for (int t = 0; t < 32; ++t) {
        if (FULL || t < nvalid) { const float t1 = __builtin_fmaf(-aim, si, xr[t]), t2 = __builtin_fmaf(aim, sr, xi[t]); const float nr = __builtin_fmaf(are, sr, t1), ni = __builtin_fmaf(are, si, t2); sr = nr; si = ni; }
        xr[t] = sr; xi[t] = si; }
#pragma unroll
    for (int i = 0; i < 4; ++i) { u32x4 a, b;
        a.x = pkh(xr[8 * i], xr[8 * i + 1]); a.y = pkh(xr[8 * i + 2], xr[8 * i + 3]); a.z = pkh(xr[8 * i + 4], xr[8 * i + 5]); a.w = pkh(xr[8 * i + 6], xr[8 * i + 7]);
        b.x = pkh(xi[8 * i], xi[8 * i + 1]); b.y = pkh(xi[8 * i + 2], xi[8 * i + 3]); b.z = pkh(xi[8 * i + 4], xi[8 * i + 5]); b.w = pkh(xi[8 * i + 6], xi[8 * i + 7]);
        *(LAS u32x4*)(S16 + l * S5_RS + 16 * i) = a; *(LAS u32x4*)(S16 + (64 + l) * S5_RS + 16 * i) = b; }
#pragma unroll
    for (int tt = 0; tt < 2; ++tt) {
        f32x4 y = {0.f, 0.f, 0.f, 0.f};
#pragma unroll
        for (int ks = 0; ks < 4; ++ks) {
            LAS unsigned char* pa = S16 + (32 * ks + 8 * q4 + (fr >> 2)) * S5_RS + (16 * tt + 4 * (fr & 3)) * 2;
            const s16x4 lo = __builtin_amdgcn_ds_read_tr16_b64_v4i16((LAS s16x4*)pa), hi = __builtin_amdgcn_ds_read_tr16_b64_v4i16((LAS s16x4*)(pa + 4 * S5_RS));
            const h8v sf = __builtin_bit_cast(h8v, (__attribute__((ext_vector_type(8))) short){lo[0], lo[1], lo[2], lo[3], hi[0], hi[1], hi[2], hi[3]});
            y = __builtin_amdgcn_mfma_f32_16x16x32_f16(cf[ks], sf, y, 0, 0, 0);
        }
        if (FULL || 16 * tt + fr < nvalid) {
            const h4v hv = tt ? hv1 : hv0;
            f32x4 v;
#pragma unroll
            for (int j = 0; j < 4; ++j) v[j] = gelu_t(y[j] + dsk[j] * (float)hv[j]);
            *(u32x2*)(gout + (16 * tt + fr) * D + 4 * q4) = pkh4(v);
        }
    }
}
template <bool FULL>
__device__ __forceinline__ void s5_item(const Frame& F, const Args& args, int seq, int g, LAS unsigned char* wl) {
    const MW& w = args.w; const int l = F.lane(), r = l & 31, h = l >> 5, q4 = l >> 4, fr = l & 15;
    const double dt = exp((double)INP(16)[g]);
    float are1, aim1, are2, aim2; double zre1, zim1, zre2, zim2;
    s5_disc(INP(14), INP(15), g, r, dt, are1, aim1, zre1, zim1);
    s5_disc(INP(14), INP(15), g, r + 32, dt, are2, aim2, zre2, zim2);
    const float are = h ? are2 : are1, aim = h ? aim2 : aim1;
    h8v bf[4];
#pragma unroll
    for (int nt = 0; nt < 4; ++nt) { const int p = (nt & 1) ? r + 32 : r; const double zr = (nt & 1) ? zre2 : zre1, zi = (nt & 1) ? zim2 : zim1;
        const float* br = INP(17) + (size_t)(g * P + p) * 16 + 8 * h; const float* bi = INP(18) + (size_t)(g * P + p) * 16 + 8 * h;
#pragma unroll
        for (int j = 0; j < 8; ++j) { const double v = (nt >> 1) ? (zr * bi[j] + zi * br[j]) : (zr * br[j] - zi * bi[j]); bf[nt][j] = (h16)(float)v; } }
    h8v cf[4];
#pragma unroll
    for (int ks = 0; ks < 4; ++ks) { const int p0 = 32 * (ks & 1) + 8 * q4; const float* src = ((ks >> 1) ? INP(20) : INP(19)) + (size_t)(g * 16 + fr) * P + p0;
#pragma unroll
        for (int j = 0; j < 8; ++j) cf[ks][j] = (h16)((ks >> 1) ? -src[j] : src[j]); }
    const f32x4 dsk = *(const f32x4*)(INP(21) + g * 16 + 4 * q4);
    float sr = 0.f, si = 0.f;
    LAS float* BU = (LAS float*)wl; LAS unsigned char* S16 = wl + S5_BU;
    if (FULL) {
        const h16* hb = w.H16 + (size_t)seq * LP * D + g * 16; h16* gb = w.G16 + (size_t)seq * LP * D + g * 16;
        const int oa = r * D + 8 * h, ob = fr * D + 4 * q4;
#define S5_LOAD(U, A, B, T) { const int tc = (T) < LP - 32 ? (T) : LP - 32; const h16* pp = hb + (size_t)tc * D; U = *(const h8v*)(pp + oa); A = *(const h4v*)(pp + ob); B = *(const h4v*)(pp + ob + 16 * D); asm volatile("" ::: "memory"); }
#define S5_CHUNK(U, A, B, T) { s5_chunk<true>(bf, cf, dsk, are, aim, sr, si, BU, S16, U, A, B, 32, gb + (size_t)(T) * D, l); asm volatile("" ::: "memory"); }
        h8v u0, u1, u2, u3; h4v a0, a1, a2, a3, b0, b1, b2, b3;
        S5_LOAD(u0, a0, b0, 0) S5_LOAD(u1, a1, b1, 32) S5_LOAD(u2, a2, b2, 64)
#pragma unroll 1
        for (int t0 = 0; t0 < LP; t0 += 128) {
            S5_LOAD(u3, a3, b3, t0 + 96)  S5_CHUNK(u0, a0, b0, t0)
            S5_LOAD(u0, a0, b0, t0 + 128) S5_CHUNK(u1, a1, b1, t0 + 32)
            S5_LOAD(u1, a1, b1, t0 + 160) S5_CHUNK(u2, a2, b2, t0 + 64)
            S5_LOAD(u2, a2, b2, t0 + 192) S5_CHUNK(u3, a3, b3, t0 + 96)
        }
#undef S5_LOAD
#undef S5_CHUNK
        w.out[O_SRE_P + (size_t)(seq * G + g) * P + l] = sr; w.out[O_SIM_P + (size_t)(seq * G + g) * P + l] = si;
    } else {
        const int sb = seq - BP, row0 = RP + sb * LS;
        sr = INP(4)[(sb * G + g) * P + l]; si = INP(5)[(sb * G + g) * P + l];
        h8v uf = {0, 0, 0, 0, 0, 0, 0, 0}; h4v hv0 = {0, 0, 0, 0};
        if (r < LS) uf = *(const h8v*)(w.H16 + (size_t)(row0 + r) * D + g * 16 + 8 * h);
        if (fr < LS) hv0 = *(const h4v*)(w.H16 + (size_t)(row0 + fr) * D + g * 16 + 4 * q4);
        s5_chunk<false>(bf, cf, dsk, are, aim, sr, si, BU, S16, uf, hv0, hv0, LS, w.G16 + (size_t)row0 * D + g * 16, l);
        w.out[O_SRE_S + (size_t)(sb * G + g) * P + l] = sr; w.out[O_SIM_S + (size_t)(sb * G + g) * P + l] = si;
    }
}
__device__ __forceinline__ void s5_phase(const Frame& F, const Args& args) {
#define BGW bg_work<0>
    if (F.wave >= 4) { BGW(F, args); return; }
    LAS unsigned char* wl = F.lds + F.wave * S5_WAVE_LDS;
    if (F.wave < 2) { for (int it = F.wave * F.G + F.bid; it < BP * G; it += 2 * F.G) s5_item<true>(F, args, it / G, it % G, wl); }
    else { for (int it = (F.wave - 2) * F.G + F.bid; it < BS * G; it += 2 * F.G) s5_item<false>(F, args, BP + it / G, it % G, wl); }
    BGW(F, args);
}
struct EpiGlu {
    static constexpr bool PERM = true;
    const h16* Gm; const float* bias; h16* O;
    __device__ __forceinline__ void operator()(const f32x4 (&acc)[2][2][4][2], const pg8::Unit& u, int wr, int wc, int fr, int fq) const {
        const int row0 = u.pm * 256 + wr * 64 + fr, col0 = u.pn * 256 + wc * 32 + 8 * fq;
        f32x4 bs[2][2];
#pragma unroll
        for (int bj = 0; bj < 2; ++bj) { bs[bj][0] = *(const f32x4*)(bias + col0 + bj * 128); bs[bj][1] = *(const f32x4*)(bias + col0 + bj * 128 + 4); }
#pragma unroll
        for (int ai = 0; ai < 2; ++ai) {
            h8v g[4][2];
#pragma unroll
            for (int m = 0; m < 4; ++m)
#pragma unroll
                for (int bj = 0; bj < 2; ++bj) g[m][bj] = *(const h8v*)(Gm + (size_t)(row0 + ai * 128 + m * 16) * D + col0 + bj * 128);
#pragma unroll
            for (int m = 0; m < 4; ++m) { const size_t ro = (size_t)(row0 + ai * 128 + m * 16) * D;
#pragma unroll
                for (int bj = 0; bj < 2; ++bj) { const int c = col0 + bj * 128; const h8v gg = g[m][bj];
                    const f32x4 v0 = acc[ai][bj][m][0] + bs[bj][0], v1 = acc[ai][bj][m][1] + bs[bj][1];
                    u32x4 w; w.x = pkh((float)gg[0] * sigm(v0[0]), (float)gg[1] * sigm(v0[1])); w.y = pkh((float)gg[2] * sigm(v0[2]), (float)gg[3] * sigm(v0[3]));
                    w.z = pkh((float)gg[4] * sigm(v1[0]), (float)gg[5] * sigm(v1[1])); w.w = pkh((float)gg[6] * sigm(v1[2]), (float)gg[7] * sigm(v1[3]));
                    *(u32x4*)(O + ro + c) = w; } }
        }
    }
};
struct EpiH16 {
    static constexpr bool PERM = true;
    h16* O; int ldc;
    __device__ __forceinline__ void operator()(const f32x4 (&acc)[2][2][4][2], const pg8::Unit& u, int wr, int wc, int fr, int fq) const {
        const int row0 = u.pm * 256 + wr * 64 + fr, col0 = u.pn * 256 + wc * 32 + 8 * fq;
#pragma unroll
        for (int ai = 0; ai < 2; ++ai)
#pragma unroll
            for (int m = 0; m < 4; ++m) { h16* rp = O + (size_t)(row0 + ai * 128 + m * 16) * ldc + col0;
#pragma unroll
                for (int bj = 0; bj < 2; ++bj) { const f32x4 v0 = acc[ai][bj][m][0], v1 = acc[ai][bj][m][1];
                    u32x4 w; w.x = pkh(v0[0], v0[1]); w.y = pkh(v0[2], v0[3]); w.z = pkh(v1[0], v1[1]); w.w = pkh(v1[2], v1[3]);
                    *(u32x4*)(rp + bj * 128) = w; } }
    }
};
struct EpiUp {
    static constexpr bool PERM = true;
    h16* O; float* cp; float* cs;
    __device__ __forceinline__ void operator()(const f32x4 (&acc)[2][2][4][2], const pg8::Unit& u, int wr, int wc, int fr, int fq) const {
        const int row0 = u.pm * 256 + wr * 64 + fr, col0 = u.pn * 256 + wc * 32 + 8 * fq;
#pragma unroll
        for (int ai = 0; ai < 2; ++ai)
#pragma unroll
            for (int m = 0; m < 4; ++m) { const int row = row0 + ai * 128 + m * 16; h16* rp = O + (size_t)row * F2 + col0;
                float* st = nullptr;
                if (row < RP) { const int t = row & (LP - 1); if (t >= LP - 2) st = cp + ((size_t)(row >> 11) * 2 + (t - (LP - 2))) * F2 + col0; }
                else { const int t = (row - RP) & 7; if (t >= LS - 2) st = cs + ((size_t)((row - RP) >> 3) * 2 + (t - (LS - 2))) * F2 + col0; }
#pragma unroll
                for (int bj = 0; bj < 2; ++bj) { const f32x4 v0 = acc[ai][bj][m][0], v1 = acc[ai][bj][m][1];
                    u32x4 w; w.x = pkh(v0[0], v0[1]); w.y = pkh(v0[2], v0[3]); w.z = pkh(v1[0], v1[1]); w.w = pkh(v1[2], v1[3]);
                    *(u32x4*)(rp + bj * 128) = w;
                    if (st) { *(f32x4*)(st + bj * 128) = v0; *(f32x4*)(st + bj * 128 + 4) = v1; } } }
    }
};
struct EpiPart {
    static constexpr bool PERM = false;
    float* O;
    __device__ __forceinline__ void operator()(const f32x4 (&acc)[2][2][4][2], const pg8::Unit& u, int wr, int wc, int fr, int fq) const {
        int row0 = wr * 64 + fr; asm volatile("" : "+v"(row0));
        const int col0 = u.pn * 256 + wc * 32 + 4 * fq; float* base = O + (size_t)u.sub * 256 * 1024 + (unsigned)(row0 * 1024 + col0);
#pragma unroll
        for (int ai = 0; ai < 2; ++ai)
#pragma unroll
            for (int m = 0; m < 4; ++m) { float* rp = base + (ai * 128 + m * 16) * 1024;
#pragma unroll
                for (int bj = 0; bj < 2; ++bj)
#pragma unroll
                    for (int n = 0; n < 2; ++n) *(f32x4*)(rp + bj * 128 + n * 16) = acc[ai][bj][m][n]; }
    }
};
__device__ __forceinline__ void conv_phase(const Frame& F, const Args& args, int layer) {
    const MW& w = args.w;
    constexpr int NCHUNK = FF / 8;
    const int ch = F.tid();
    if (ch >= NCHUNK) return;
    const float* cw = (const float*)args.in[25] + (size_t)layer * 3 * F2; const float* cb = (const float*)args.in[26] + (size_t)layer * F2;
    const float* prefix = (const float*)args.in[6] + (size_t)layer * BS * 2 * F2;
    const int j0 = ch * 8;
    float wa[3][8], wg[3][8], ba[8], bg[8];
#pragma unroll
    for (int k = 0; k < 3; ++k)
#pragma unroll
        for (int e = 0; e < 8; ++e) { wa[k][e] = cw[k * F2 + j0 + e]; wg[k][e] = cw[k * F2 + FF + j0 + e]; }
#pragma unroll
    for (int e = 0; e < 8; ++e) { ba[e] = cb[j0 + e]; bg[e] = cb[FF + j0 + e]; }
    constexpr int NSEG_P = RP / 64, NSEG = NSEG_P + BS;
    for (int seg = F.bid; seg < NSEG; seg += F.G) {
        int jj = j0; asm volatile("" : "+v"(jj));
        int row0, nrows; h8v p0a, p1a, p0g, p1g;
        if (seg < NSEG_P) {
            row0 = seg * 64; nrows = 64; const int t0 = row0 & (LP - 1);
            if (t0 == 0) {
#pragma unroll
                for (int e = 0; e < 8; ++e) { p0a[e] = 0; p1a[e] = 0; p0g[e] = 0; p1g[e] = 0; }
            } else {
                p0a = *(const h8v*)(w.UP16 + (size_t)(row0 - 2) * F2 + jj); p1a = *(const h8v*)(w.UP16 + (size_t)(row0 - 1) * F2 + jj);
                p0g = *(const h8v*)(w.UP16 + (size_t)(row0 - 2) * F2 + FF + jj); p1g = *(const h8v*)(w.UP16 + (size_t)(row0 - 1) * F2 + FF + jj);
            }
        } else {
            const int b = seg - NSEG_P; row0 = RP + b * LS; nrows = LS;
#pragma unroll
            for (int e = 0; e < 8; ++e) { p0a[e] = (h16)prefix[((size_t)b * 2 + 0) * F2 + jj + e]; p1a[e] = (h16)prefix[((size_t)b * 2 + 1) * F2 + jj + e];
                                          p0g[e] = (h16)prefix[((size_t)b * 2 + 0) * F2 + FF + jj + e]; p1g[e] = (h16)prefix[((size_t)b * 2 + 1) * F2 + FF + jj + e]; }
        }
        h8v ua[4], ug[4], na[4], ng[4];
#pragma unroll
        for (int q = 0; q < 4; ++q) { ua[q] = *(const h8v*)(w.UP16 + (size_t)(row0 + q) * F2 + jj); ug[q] = *(const h8v*)(w.UP16 + (size_t)(row0 + q) * F2 + FF + jj); }
#pragma unroll
        for (int q = 0; q < 4; ++q) { asm volatile("" : "+v"(ua[q])); asm volatile("" : "+v"(ug[q])); }
#pragma unroll 1
        for (int t = 0; t < nrows; t += 4) {
            { const int tn = t + 4 < nrows ? t + 4 : t;
#pragma unroll
                for (int q = 0; q < 4; ++q) { na[q] = *(const h8v*)(w.UP16 + (size_t)(row0 + tn + q) * F2 + jj); ng[q] = *(const h8v*)(w.UP16 + (size_t)(row0 + tn + q) * F2 + FF + jj); }
                asm volatile("" ::: "memory");
#pragma unroll
                for (int q = 0; q < 4; ++q) { asm volatile("" : "+v"(ua[q])); asm volatile("" : "+v"(ug[q])); }
            }
#pragma unroll
            for (int q = 0; q < 4; ++q) {
                float o[8];
                const h8v r0a = q >= 2 ? ua[q >= 2 ? q - 2 : 0] : (q == 1 ? p1a : p0a), r1a = q >= 1 ? ua[q >= 1 ? q - 1 : 0] : p1a;
                const h8v r0g = q >= 2 ? ug[q >= 2 ? q - 2 : 0] : (q == 1 ? p1g : p0g), r1g = q >= 1 ? ug[q >= 1 ? q - 1 : 0] : p1g;
#pragma unroll
                for (int e = 0; e < 8; ++e) { const float a2 = (float)ua[q][e], g2 = (float)ug[q][e];
                    const float ca = ba[e] + wa[0][e] * (float)r0a[e] + wa[1][e] * (float)r1a[e] + wa[2][e] * a2;
                    const float cg = bg[e] + wg[0][e] * (float)r0g[e] + wg[1][e] * (float)r1g[e] + wg[2][e] * g2;
                    o[e] = silu(cg) * ca; }
                u32x4 pk; pk.x = pkh(o[0], o[1]); pk.y = pkh(o[2], o[3]); pk.z = pkh(o[4], o[5]); pk.w = pkh(o[6], o[7]);
                *(u32x4*)(w.ACT16 + (size_t)(row0 + t + q) * FF + jj) = pk;
            }
            p0a = ua[2]; p1a = ua[3]; p0g = ug[2]; p1g = ug[3];
#pragma unroll
            for (int q = 0; q < 4; ++q) { ua[q] = na[q]; ug[q] = ng[q]; }
        }
    }
}

struct EpiKvQg {
    static constexpr bool PERM = true;
    const float2* ROPE; h16* KV16; h16* CMPP; float* out; h16* QP16; h16* QR16; float* GATE;
    __device__ __forceinline__ void operator()(const f32x4 (&acc)[2][2][4][2], const pg8::Unit& u, int wr, int wc, int fr, int fq) const {
        const int row0 = u.pm * 256 + wr * 64 + fr, col0 = u.pn * 256 + wc * 32 + 8 * fq;
        const int i0 = (col0 & 63) >> 1;
        const bool anyrope = u.sub != 0 || (u.pn >= 2 && u.pn < 5);
#pragma unroll
        for (int ai = 0; ai < 2; ++ai) {
            f32x4 rc[4][2];
            if (anyrope) {
#pragma unroll
                for (int m = 0; m < 4; ++m) { const float2* rp = ROPE + ropeidx(row0 + ai * 128 + m * 16) * 32 + i0; rc[m][0] = *(const f32x4*)rp; rc[m][1] = *(const f32x4*)(rp + 2); }
            }
#pragma unroll
            for (int m = 0; m < 4; ++m) { const int row = row0 + ai * 128 + m * 16;
                const f32x4 cv = {rc[m][0][0], rc[m][0][2], rc[m][1][0], rc[m][1][2]}, sv = {rc[m][0][1], rc[m][0][3], rc[m][1][1], rc[m][1][3]};
#pragma unroll
                for (int bj = 0; bj < 2; ++bj) { const int c = col0 + bj * 128; f32x4 a = acc[ai][bj][m][0], b = acc[ai][bj][m][1];                    const int hb = c >> 6;
                    if (u.sub == 0) {
                        const int s6 = hb >> 2, kvh = hb & 3;
                        if (s6 == 2 || s6 == 4) { const f32x4 ta = a * cv - b * sv, tb = b * cv + a * sv; a = ta; b = tb; }
                        if (s6 < 4) { float* o = out + O_ROWS + (size_t)row * 1024 + s6 * 256 + kvh * 64 + i0; *(f32x4*)o = a; *(f32x4*)(o + 32) = b; }
                        else { const int s2 = s6 - 4; float* o = nullptr;
                            if (row < RP) { const int t = row & (LP - 1); if (t >= LP - WIN) o = out + O_WIN_P + ((size_t)((row >> 11) * WIN + t - (LP - WIN)) * 2 + s2) * 256 + kvh * 64 + i0; }
                            else o = out + O_WIN_S + ((size_t)(row - RP) * 2 + s2) * 256 + kvh * 64 + i0;
                            if (o) { *(f32x4*)o = a; *(f32x4*)(o + 32) = b; } }
                        if (s6 >= 2) { h16* k = KV16 + (size_t)row * 1024 + (s6 - 2) * 256 + kvh * 64 + i0; *(u32x2*)k = pkh4(a); *(u32x2*)(k + 32) = pkh4(b); }
                        else if (row < RP) { h16* k = CMPP + (size_t)row * 512 + s6 * 256 + kvh * 64 + i0; *(u32x2*)k = pkh4(a); *(u32x2*)(k + 32) = pkh4(b); }
                    } else if (c < 1024) {
                        h16* qp = QP16 + (size_t)row * D + hb * 64 + i0; h16* qr = QR16 + (size_t)row * D + hb * 64 + i0;
                        constexpr float QS = 0.125f * 1.4426950408889634f;
                        *(u32x2*)qp = pkh4(a * QS); *(u32x2*)(qp + 32) = pkh4(b * QS);
                        *(u32x2*)qr = pkh4((a * cv - b * sv) * QS); *(u32x2*)(qr + 32) = pkh4((b * cv + a * sv) * QS);
                    } else if (c < NQG) {
                        f32x4 g0, g1;
#pragma unroll
                        for (int e = 0; e < 4; ++e) { g0[e] = sigm(a[e]); g1[e] = sigm(b[e]); }
                        float* gp = GATE + (size_t)row * 48 + (c - 1024); *(f32x4*)gp = g0; *(f32x4*)(gp + 4) = g1;
                    }
                } }
        }
    }
};
struct KvQgOrder {
    pg8::StaticOrder a, b; int G, c;
    __device__ void init(int G_, int c_) { G = G_; c = c_; a.init(R, NKV, 1, 0); b.init(R, 1280, 1, 0); }
    __device__ bool next(int i, pg8::Unit& u) const {
        const int L = i * G + c;
        if (L < a.nwg) { a.next(L, u); u.sub = 0; return true; }
        if (L < a.nwg + b.nwg) { b.next(L - a.nwg, u); u.sub = 1; return true; }
        return false;
    }
};
struct KvQgLay {
    const h16 *A0, *B0, *A1, *B1;
    __device__ __forceinline__ unsigned a_rowoff(int r) const { return (unsigned)r * 2048u; }
    __device__ __forceinline__ unsigned b_rowoff(int r) const { return (unsigned)r * 2048u; }
    __device__ __forceinline__ size_t a_kstep() const { return 128; }
    __device__ __forceinline__ const char* a_ptr(const pg8::Unit& u) const { return (const char*)(u.sub ? A1 : A0) + (size_t)u.pm * 256 * 2048; }
    __device__ __forceinline__ const char* b_ptr(const pg8::Unit& u) const { return (const char*)(u.sub ? B1 : B0) + (size_t)u.pn * 256 * 2048; }
};

struct CmpOrderS {
    int G, c;
    __device__ bool next(int i, pg8::Unit& u) const { const int L = i * G + c; if (L >= 512) return false; u.pn = 0; u.sub = L >> 8; u.pm = L & 255; return true; }
};
struct CmpOrderP {
    int G, c;
    __device__ bool next(int i, pg8::Unit& u) const { const int L = i * G + c; if (L >= 128) return false; u.pn = 0; const int rest = L >> 2; u.sub = (rest >> 4) + 2 * (L & 3); u.pm = rest & 15; return true; }
};
struct CmpLayS {
    const h16 *CS, *Wk, *Wv;
    __device__ __forceinline__ unsigned a_rowoff(int r) const { return (unsigned)(r >> 2) * 16384u + (unsigned)(r & 3) * 128u; }
    __device__ __forceinline__ unsigned b_rowoff(int r) const { return (unsigned)r * 2048u; }
    __device__ __forceinline__ size_t a_kstep() const { return 1024; }
    __device__ __forceinline__ const char* a_ptr(const pg8::Unit& u) const { return (const char*)(CS + ((size_t)(u.pm >> 3) * PAST + (size_t)(u.pm & 7) * 1024) * 512 + (u.sub & 1) * 256); }
    __device__ __forceinline__ const char* b_ptr(const pg8::Unit& u) const { return (const char*)((u.sub & 1) ? Wv : Wk); }
};
struct CmpLayP {
    const h16 *CP, *Wk, *Wv;
    __device__ __forceinline__ unsigned a_rowoff(int r) const { return (unsigned)(r >> 2) * 16384u + (unsigned)(r & 3) * 128u; }
    __device__ __forceinline__ unsigned b_rowoff(int r) const { return (unsigned)r * 2048u; }
    __device__ __forceinline__ size_t a_kstep() const { return 1024; }
    __device__ __forceinline__ const char* a_ptr(const pg8::Unit& u) const { return (const char*)(CP + ((size_t)(u.pm >> 1) * LP + (size_t)(u.pm & 1) * 1024 + (size_t)(u.sub >> 1) * 4) * 512 + (u.sub & 1) * 256); }
    __device__ __forceinline__ const char* b_ptr(const pg8::Unit& u) const { return (const char*)((u.sub & 1) ? Wv : Wk) + (size_t)(u.sub >> 1) * 512; }
};
struct EpiCmpP {
    static constexpr bool PERM = false, AFTER_DRAIN = false;
    float* PB;
    __device__ __forceinline__ void operator()(const f32x4 (&acc)[2][2][4][2], const pg8::Unit& u, int wr, int wc, int fr, int fq) const {
        float* O = PB + (size_t)((u.sub >> 1) * 2 + (u.sub & 1)) * 4096 * 256;
        const int row0 = u.pm * 256 + wr * 64 + fr, col0 = wc * 32 + 4 * fq; float* ob = O + (size_t)row0 * 256 + col0;
#pragma unroll
        for (int ai = 0; ai < 2; ++ai)
#pragma unroll
            for (int m = 0; m < 4; ++m) { float* rp = ob + (ai * 128 + m * 16) * 256;
#pragma unroll
                for (int bj = 0; bj < 2; ++bj)
#pragma unroll
                    for (int n = 0; n < 2; ++n) *(f32x4*)(rp + bj * 128 + n * 16) = acc[ai][bj][m][n]; }
    }
};
struct EpiCmpS {
    static constexpr bool PERM = true, AFTER_DRAIN = false;
    h16* PB;
    __device__ __forceinline__ void operator()(const f32x4 (&acc)[2][2][4][2], const pg8::Unit& u, int wr, int wc, int fr, int fq) const {
        h16* ob = PB + (size_t)(u.sub & 1) * 65536 * 256 + (size_t)(u.pm * 256 + wr * 64 + fr) * 256 + wc * 32 + 8 * fq;
#pragma unroll
        for (int ai = 0; ai < 2; ++ai)
#pragma unroll
            for (int m = 0; m < 4; ++m) { h16* rp = ob + (ai * 128 + m * 16) * 256;
#pragma unroll
                for (int bj = 0; bj < 2; ++bj) { const f32x4 v0 = acc[ai][bj][m][0], v1 = acc[ai][bj][m][1];
                    u32x4 w; w.x = pkh(v0[0], v0[1]); w.y = pkh(v0[2], v0[3]); w.z = pkh(v1[0], v1[1]); w.w = pkh(v1[2], v1[3]);
                    *(u32x4*)(rp + bj * 128) = w; } }
    }
};
constexpr int C2_HST = 272;
__device__ __forceinline__ void cmp2_phase(const Frame& F, const Args& args) {
    const MW& w = args.w; const int l = F.lane(), r = l & 31, h2 = l >> 5;
    const int gw = F.bid * NW + F.wave, NGW = F.G * NW;
    constexpr int TP = BP * NC_P * 4 / 32, TS = BS * NC_S * 4 / 32;
    {
        float wv[4][8];
#pragma unroll
        for (int q = 0; q < 4; ++q) { const int f = F.tid() + q * NT; const int fl = f & 63, nt = (f >> 6) & 1, ks = (f >> 7) & 7, slot = f >> 10;
            const float* w2 = (const float*)args.in[35] + (size_t)slot * 128 * 64 + (size_t)(16 * ks + 8 * (fl >> 5)) * 64 + 32 * nt + (fl & 31);
#pragma unroll
            for (int j = 0; j < 8; ++j) wv[q][j] = w2[64 * j]; }
#pragma unroll
        for (int q = 0; q < 4; ++q) { const int f = F.tid() + q * NT;
            u32x4 o; o.x = pkh(wv[q][0], wv[q][1]); o.y = pkh(wv[q][2], wv[q][3]); o.z = pkh(wv[q][4], wv[q][5]); o.w = pkh(wv[q][6], wv[q][7]);
            *(LAS u32x4*)(F.lds + (size_t)f * 16) = o; }
    }
    __syncthreads();
    LAS unsigned char* HL = F.lds + 32768 + F.wave * (32 * C2_HST);
    const int srow = l >> 4, sc = l & 15;
    for (int tile = gw; tile < 2 * (TP + TS); tile += NGW) {
        const int slot = tile >= TP + TS ? 1 : 0; const int t2 = tile - slot * (TP + TS);
        const bool samp = t2 >= TP; const int tl = samp ? t2 - TP : t2;
        const int nc = samp ? NC_S : NC_P, nch = samp ? 512 : 128;
        h16* KC = samp ? (slot ? w.VC16s : w.KC16s) : (slot ? w.VC16p : w.KC16p);
        const f32x4 c0 = *(const f32x4*)(w.CB + slot * 128 + sc * 8), c1 = *(const f32x4*)(w.CB + slot * 128 + sc * 8 + 4);
        if (samp) {
            h8v xa[8], ya[8];
#pragma unroll
            for (int it = 0; it < 8; ++it) {
                const int rho = tl * 32 + it * 4 + srow; const int kvh = rho & 3, bi = rho >> 2, b = bi / NC_S, i = bi % NC_S;
                const h16* PBh = w.PBs16 + (size_t)slot * 65536 * 256 + ((size_t)(b * 512 + i) * 4 + kvh) * 256 + sc * 8; xa[it] = *(const h8v*)PBh; ya[it] = *(const h8v*)(PBh + 4 * 256 + 128); }
#pragma unroll
            for (int it = 0; it < 8; ++it) { f32x4 x0, x1;
#pragma unroll
                for (int j = 0; j < 4; ++j) { x0[j] = (float)xa[it][j] + (float)ya[it][j]; x1[j] = (float)xa[it][4 + j] + (float)ya[it][4 + j]; }
                u32x4 hv; hv.x = pkh(gelu_t(x0[0] + c0[0]), gelu_t(x0[1] + c0[1])); hv.y = pkh(gelu_t(x0[2] + c0[2]), gelu_t(x0[3] + c0[3]));
                hv.z = pkh(gelu_t(x1[0] + c1[0]), gelu_t(x1[1] + c1[1])); hv.w = pkh(gelu_t(x1[2] + c1[2]), gelu_t(x1[3] + c1[3]));
                *(LAS u32x4*)(HL + (it * 4 + srow) * C2_HST + sc * 16) = hv; }
        } else {
#pragma unroll
            for (int i2 = 0; i2 < 8; i2 += 2) {
                f32x4 t[2][4][4];
#pragma unroll
                for (int d = 0; d < 2; ++d) { const int rho = tl * 32 + (i2 + d) * 4 + srow; const int kvh = rho & 3, bi = rho >> 2, b = bi / NC_P, i = bi % NC_P;
                    const float* p0 = w.PBp + (size_t)slot * 4096 * 256 + ((size_t)(b * 128 + i) * 4 + kvh) * 256 + sc * 8; const float* p1 = p0 + 4 * 256 + 128;
#pragma unroll
                    for (int sl = 0; sl < 4; ++sl) { const size_t so = (size_t)sl * 2 * 4096 * 256; t[d][sl][0] = *(const f32x4*)(p0 + so); t[d][sl][1] = *(const f32x4*)(p1 + so); t[d][sl][2] = *(const f32x4*)(p0 + so + 4); t[d][sl][3] = *(const f32x4*)(p1 + so + 4); } }
#pragma unroll
                for (int d = 0; d < 2; ++d) { f32x4 x0 = t[d][0][0] + t[d][0][1], x1 = t[d][0][2] + t[d][0][3];
#pragma unroll
                    for (int sl = 1; sl < 4; ++sl) { x0 += t[d][sl][0] + t[d][sl][1]; x1 += t[d][sl][2] + t[d][sl][3]; }
                    u32x4 hv; hv.x = pkh(gelu_t(x0[0] + c0[0]), gelu_t(x0[1] + c0[1])); hv.y = pkh(gelu_t(x0[2] + c0[2]), gelu_t(x0[3] + c0[3]));
                    hv.z = pkh(gelu_t(x1[0] + c1[0]), gelu_t(x1[1] + c1[1])); hv.w = pkh(gelu_t(x1[2] + c1[2]), gelu_t(x1[3] + c1[3]));
                    *(LAS u32x4*)(HL + ((i2 + d) * 4 + srow) * C2_HST + sc * 16) = hv; }
            }
        }
        const LAS unsigned char* wfp = F.lds + (size_t)slot * 16384 + l * 16;
        f32x16 acc0 = {0.f, 0.f, 0.f, 0.f, 0.f, 0.f, 0.f, 0.f, 0.f, 0.f, 0.f, 0.f, 0.f, 0.f, 0.f, 0.f}, acc1 = acc0;
#pragma unroll
        for (int ks = 0; ks < 8; ++ks) {
            const h8v hf = *(const LAS h8v*)(HL + r * C2_HST + (16 * ks + 8 * h2) * 2);
            const h8v b0 = *(const LAS h8v*)(wfp + (ks * 2 + 0) * 1024), b1 = *(const LAS h8v*)(wfp + (ks * 2 + 1) * 1024);
            acc0 = __builtin_amdgcn_mfma_f32_32x32x16_f16(hf, b0, acc0, 0, 0, 0);
            acc1 = __builtin_amdgcn_mfma_f32_32x32x16_f16(hf, b1, acc1, 0, 0, 0);
        }
#pragma unroll
        for (int rg = 0; rg < 16; ++rg) { const int orow = tl * 32 + (rg & 3) + 8 * (rg >> 2) + 4 * h2; KC[(size_t)orow * 64 + r] = (h16)acc0[rg]; KC[(size_t)orow * 64 + 32 + r] = (h16)acc1[rg]; }
    }
    __syncthreads();
}
__device__ __forceinline__ float ex2(float x) { return __builtin_amdgcn_exp2f(x); }
constexpr int AT_KST = 144, AT_KB = 64 * AT_KST, AT_VB = 8192, AT_BUF = AT_KB + AT_VB;
__device__ __forceinline__ int kaddr(int row, int c) { return row * AT_KST + c * 16; }
__device__ __forceinline__ constexpr int keyc(int kt, int reg) { return 32 * kt + (reg & 3) + 8 * (reg >> 2); }
__device__ __forceinline__ float xhalf(float v) { return __shfl_xor(v, 32); }
__device__ __forceinline__ void qk64(const LAS unsigned char* KT, const h8v (&qf)[4], f32x16 (&st)[2], int r, int h) {
#pragma unroll
    for (int kt = 0; kt < 2; ++kt) { f32x16 a = {0.f, 0.f, 0.f, 0.f, 0.f, 0.f, 0.f, 0.f, 0.f, 0.f, 0.f, 0.f, 0.f, 0.f, 0.f, 0.f};
#pragma unroll
        for (int ks = 0; ks < 4; ++ks) { const h8v kf = *(const LAS h8v*)(KT + (r * AT_KST + h * 16) + (32 * kt * AT_KST + 32 * ks)); a = __builtin_amdgcn_mfma_f32_32x32x16_f16(kf, qf[ks], a, 0, 0, 0); }
        st[kt] = a; }
}
__device__ __forceinline__ h8v vfrag(const LAS unsigned char* VT, int keybase, int dt, int l) {
    const int h = l >> 5, i = l & 15, q = i >> 2, p = i & 3;
    const LAS unsigned char* a = VT + ((4 * h + q) * 128 + (16 * ((l >> 4) & 1) + 4 * p) * 2) + (keybase * 128 + 64 * dt);
    const s16x4 lo = __builtin_amdgcn_ds_read_tr16_b64_v4i16((LAS s16x4*)a), hi = __builtin_amdgcn_ds_read_tr16_b64_v4i16((LAS s16x4*)(a + 8 * 128));
    return __builtin_bit_cast(h8v, (__attribute__((ext_vector_type(8))) short){lo[0], lo[1], lo[2], lo[3], hi[0], hi[1], hi[2], hi[3]});
}
__device__ __forceinline__ void pv64(const f32x16 (&p)[2], const LAS unsigned char* VT, f32x16 (&o)[2], int l) {
#pragma unroll
    for (int kt = 0; kt < 2; ++kt)
#pragma unroll
        for (int s = 0; s < 2; ++s) { h8v pf;
#pragma unroll
            for (int j = 0; j < 8; ++j) pf[j] = (h16)p[kt][8 * s + j];
#pragma unroll
            for (int dt = 0; dt < 2; ++dt) { const h8v vf = vfrag(VT, 32 * kt + 16 * s, dt, l); o[dt] = __builtin_amdgcn_mfma_f32_32x32x16_f16(vf, pf, o[dt], 0, 0, 0); } }
}
struct AttSt { float mrun, lrun; f32x16 o[2]; };
__device__ __forceinline__ void att_reset(AttSt& S) { S.mrun = NEG; S.lrun = 0.f;
#pragma unroll
    for (int dt = 0; dt < 2; ++dt) S.o[dt] = (f32x16){0.f, 0.f, 0.f, 0.f, 0.f, 0.f, 0.f, 0.f, 0.f, 0.f, 0.f, 0.f, 0.f, 0.f, 0.f, 0.f}; }
template <class MaskF> __device__ __forceinline__ void sm_pv64(f32x16 (&st)[2], const LAS unsigned char* VT, AttSt& S, bool anymask, MaskF valid, int l) {
    float mx = NEG;
    if (anymask) {
#pragma unroll
        for (int kt = 0; kt < 2; ++kt)
#pragma unroll
            for (int reg = 0; reg < 16; ++reg) { const float v = valid(keyc(kt, reg)) ? st[kt][reg] : NEG; st[kt][reg] = v; mx = fmaxf(mx, v); }
    } else {
#pragma unroll
        for (int kt = 0; kt < 2; ++kt)
#pragma unroll
            for (int reg = 0; reg < 16; reg += 2) mx = fmaxf(mx, fmaxf(st[kt][reg], st[kt][reg + 1]));
    }
    mx = fmaxf(mx, xhalf(mx));
    const float mnew = fmaxf(S.mrun, mx), alpha = ex2(S.mrun - mnew); float ls = 0.f;
    if (anymask) {
#pragma unroll
        for (int kt = 0; kt < 2; ++kt)
#pragma unroll
            for (int reg = 0; reg < 16; ++reg) { const float v = st[kt][reg]; const float p = (v <= 0.5f * NEG) ? 0.f : ex2(v - mnew); st[kt][reg] = p; ls += p; }
    } else {
#pragma unroll
        for (int kt = 0; kt < 2; ++kt)
#pragma unroll
            for (int reg = 0; reg < 16; ++reg) { const float p = ex2(st[kt][reg] - mnew); st[kt][reg] = p; ls += p; }
    }
    S.lrun = S.lrun * alpha + ls; S.mrun = mnew;
    if (!__all(alpha == 1.f)) {
#pragma unroll
        for (int dt = 0; dt < 2; ++dt)
#pragma unroll
            for (int reg = 0; reg < 16; ++reg) S.o[dt][reg] *= alpha; }
    pv64(st, VT, S.o, l);
}
__device__ __forceinline__ void att_fold(f32x16 (&tot)[2], const AttSt& S, float gate) {
    const float lt = S.lrun + xhalf(S.lrun); const float sc = lt > 0.f ? gate / lt : 0.f;
#pragma unroll
    for (int dt = 0; dt < 2; ++dt)
#pragma unroll
        for (int reg = 0; reg < 16; ++reg) tot[dt][reg] += sc * S.o[dt][reg];
}
__device__ __forceinline__ void att_store(const f32x16 (&tot)[2], h16* dst  , int h) {
#pragma unroll
    for (int dt = 0; dt < 2; ++dt)
#pragma unroll
        for (int g4 = 0; g4 < 4; ++g4) { const int d0 = 32 * dt + 8 * g4 + 4 * h;
            *(u32x2*)(dst + d0) = pkh4((f32x4){tot[dt][4 * g4], tot[dt][4 * g4 + 1], tot[dt][4 * g4 + 2], tot[dt][4 * g4 + 3]}); }
}

constexpr int ATP_SCI = 4 * AT_BUF, ATP_SCL = ATP_SCI + 32768, ATP_TOT = ATP_SCL + 32768, ATP_MASK = ATP_TOT + 8192;
__device__ __forceinline__ void attn_prompt_unit(const Frame& F, const Args& args, int b, int kvh, int m) {
    const MW& w = args.w; int l = F.lane(); asm volatile("" : "+v"(l));
    const int r = l & 31, h = l >> 5, qsub = F.wave >> 2, gh = F.wave & 3, head = kvh * 4 + gh;
    const int qloc = 32 * qsub + r, qpos = 64 * m + qloc, qrow = b * LP + qpos;
    LAS unsigned char* L = F.lds;
    LAS float* SCI = (LAS float*)(L + ATP_SCI); LAS float* SCL = (LAS float*)(L + ATP_SCL); LAS float* TOT = (LAS float*)(L + ATP_TOT); LAS unsigned* MASK = (LAS unsigned*)(L + ATP_MASK);
    int tid = F.tid(); asm volatile("" : "+v"(tid));
    const int srow = tid >> 3, sc8 = tid & 7;
#pragma unroll
    for (int T = 0; T < 2; ++T) { const int i = 64 * T + srow; u32x4 kk = {0u, 0u, 0u, 0u}, vv = {0u, 0u, 0u, 0u};
        if (i < NC_P) { const size_t o = ((size_t)(b * NC_P + i) * 4 + kvh) * 64 + sc8 * 8; kk = *(const u32x4*)(w.KC16p + o); vv = *(const u32x4*)(w.VC16p + o); }
        *(LAS u32x4*)(L + T * AT_BUF + kaddr(srow, sc8)) = kk; *(LAS u32x4*)(L + T * AT_BUF + AT_KB + srow * 128 + sc8 * 16) = vv; }
    if (tid < 64) MASK[tid] = 0u;
    const float* gt = w.GATE + (size_t)qrow * 48;
    h8v qf[4];
#pragma unroll
    for (int ks = 0; ks < 4; ++ks) qf[ks] = *(const h8v*)(w.QP16 + (size_t)qrow * D + head * 64 + 16 * ks + 8 * h);
    __syncthreads();
    f32x16 tot[2];
    {
        f32x16 s0[2], s1[2]; qk64(L, qf, s0, r, h); qk64(L + AT_BUF, qf, s1, r, h);
        const int qc = qpos - 31 - 64 * h, c1lim = NC_P - 64 - 4 * h;
        float mx = NEG;
#pragma unroll
        for (int kt = 0; kt < 2; ++kt)
#pragma unroll
            for (int reg = 0; reg < 16; ++reg) { const int kc = keyc(kt, reg);
                const float v0 = (16 * kc <= qc) ? s0[kt][reg] : NEG, v1 = (kc < c1lim && 16 * kc + 1024 <= qc) ? s1[kt][reg] : NEG; s0[kt][reg] = v0; s1[kt][reg] = v1; mx = fmaxf(mx, fmaxf(v0, v1)); }
        mx = fmaxf(mx, xhalf(mx)); float sum = 0.f;
#pragma unroll
        for (int kt = 0; kt < 2; ++kt)
#pragma unroll
            for (int reg = 0; reg < 16; ++reg) { const float p0 = (s0[kt][reg] <= 0.5f * NEG) ? 0.f : ex2(s0[kt][reg] - mx), p1 = (s1[kt][reg] <= 0.5f * NEG) ? 0.f : ex2(s1[kt][reg] - mx); s0[kt][reg] = p0; s1[kt][reg] = p1; sum += p0 + p1; }
        sum += xhalf(sum); const float inv = sum > 0.f ? 1.f / sum : 0.f;
#pragma unroll
        for (int kt = 0; kt < 2; ++kt)
#pragma unroll
            for (int reg = 0; reg < 16; ++reg) { s0[kt][reg] *= inv; s1[kt][reg] *= inv; }
        { LAS float* sci = SCI + (gh * 32 + h) * 64 + qloc; LAS float* scl = SCL + (gh * 32 + h) * 64 + qloc;
#pragma unroll
        for (int kt = 0; kt < 2; ++kt)
#pragma unroll
            for (int g4 = 0; g4 < 4; ++g4) { constexpr int dummy = 0; (void)dummy; const int o0 = (8 * kt + 2 * g4) * 64, o1 = o0 + 16 * 64;
                sci[o0] = 2.f * (s0[kt][4 * g4] + s0[kt][4 * g4 + 1] + s0[kt][4 * g4 + 2]) + s0[kt][4 * g4 + 3]; scl[o0] = s0[kt][4 * g4 + 3];
                sci[o1] = 2.f * (s1[kt][4 * g4] + s1[kt][4 * g4 + 1] + s1[kt][4 * g4 + 2]) + s1[kt][4 * g4 + 3]; scl[o1] = s1[kt][4 * g4 + 3]; } }
        f32x16 oc[2];
#pragma unroll
        for (int dt = 0; dt < 2; ++dt) oc[dt] = (f32x16){0.f, 0.f, 0.f, 0.f, 0.f, 0.f, 0.f, 0.f, 0.f, 0.f, 0.f, 0.f, 0.f, 0.f, 0.f, 0.f};
        pv64(s0, L + AT_KB, oc, l); pv64(s1, L + AT_BUF + AT_KB, oc, l);
#pragma unroll
        for (int dt = 0; dt < 2; ++dt)
#pragma unroll
            for (int reg = 0; reg < 16; ++reg) tot[dt][reg] = gt[head] * oc[dt][reg];
    }
#pragma unroll
    for (int ks = 0; ks < 4; ++ks) qf[ks] = *(const h8v*)(w.QR16 + (size_t)qrow * D + head * 64 + 16 * ks + 8 * h);
    __syncthreads();
    {
        const int q = l, jg = F.wave; float me[4];
        const LAS float* sci = SCI + 4 * jg * 64 + q; const LAS float* scl = SCL + (4 * jg - 1) * 64 + q; LAS float* totw = TOT + 4 * jg * 64 + q;
#pragma unroll
        for (int e = 0; e < 4; ++e) { const int j = 4 * jg + e; float a = 0.f;
#pragma unroll
            for (int g = 0; g < 4; ++g) { a += sci[(g * 32 + e) * 64]; if (j > 0) a += scl[(g * 32 + e) * 64]; }
            const bool forced = (j == 0) || (j == m) || (j == m - 1);
            me[e] = forced ? INFINITY : (j <= m ? a : -INFINITY); totw[e * 64] = me[e]; }
        __syncthreads();
        unsigned bits = 0u;
        if (m < NSEL) {
#pragma unroll
            for (int e = 0; e < 4; ++e) if (4 * jg + e <= m) bits |= 1u << (4 * jg + e);
        } else {
            int rank[4] = {0, 0, 0, 0};
#pragma unroll 1
            for (int j2 = 0; j2 < 32; ++j2) { const float o = (TOT + q)[j2 * 64];
#pragma unroll
                for (int e = 0; e < 4; ++e) rank[e] += (o > me[e] || (o == me[e] && j2 < 4 * jg + e)) ? 1 : 0; }
#pragma unroll
            for (int e = 0; e < 4; ++e) if (rank[e] < NSEL) bits |= 1u << (4 * jg + e);
        }
        if (bits) atomicOr((unsigned*)(MASK + q), bits);
    }
    __syncthreads();
    const unsigned mq = MASK[qloc];
    const int n_sel = m + 1, w0 = m > 8 ? m - 8 : 0, n_all = n_sel + (m - w0 + 1);
    const h16* kvb = w.KV16 + (size_t)b * LP * 1024 + kvh * 64 + sc8 * 8;
    u32x4 kk0, vv0, kk1, vv1;
#define AT_LOAD1(t, K_, V_) do { if ((t) < n_all) { const int jb_ = (t) < n_sel ? (t) : w0 + (t) - n_sel; const h16* p_ = kvb + (size_t)(64 * jb_ + srow) * 1024 + ((t) < n_sel ? 0 : 512); K_ = *(const u32x4*)p_; V_ = *(const u32x4*)(p_ + 256); } } while (0)
#define AT_LOAD(p) do { AT_LOAD1(2 * (p), kk0, vv0); AT_LOAD1(2 * (p) + 1, kk1, vv1); } while (0)
#define AT_PUT(buf) do { int bo_ = (buf) * 2 * AT_BUF; asm volatile("" : "+v"(bo_)); LAS unsigned char* q_ = L + bo_; \
        *(LAS u32x4*)(q_ + kaddr(srow, sc8)) = kk0; *(LAS u32x4*)(q_ + AT_KB + srow * 128 + sc8 * 16) = vv0; \
        *(LAS u32x4*)(q_ + AT_BUF + kaddr(srow, sc8)) = kk1; *(LAS u32x4*)(q_ + AT_BUF + AT_KB + srow * 128 + sc8 * 16) = vv1; } while (0)
    const int np = (n_all + 1) >> 1;
    AT_LOAD(0); AT_PUT(0);
    if (np > 1) AT_LOAD(1);
    __syncthreads();
    AttSt S; att_reset(S);
    const int qd = qloc - 4 * h;
    for (int pp = 0; pp < np; ++pp) {
        if (pp + 1 < np) AT_PUT((pp + 1) & 1);
        if (pp + 2 < np) AT_LOAD(pp + 2);
#pragma unroll
        for (int u2 = 0; u2 < 2; ++u2) {
            const int t = 2 * pp + u2;
            if (t < n_all) {
                int bo = ((pp & 1) * 2 + u2) * AT_BUF; asm volatile("" : "+v"(bo));
                const LAS unsigned char* KT = L + bo;
                if (t == n_sel) { att_fold(tot, S, gt[16 + head]); att_reset(S); }
                if (t < n_sel) {
                    const int jb = t; const bool selq = (mq >> jb) & 1u;
                    if (__any(selq)) { f32x16 st[2]; qk64(KT, qf, st, r, h); const bool diag = jb == m;
                        sm_pv64(st, KT + AT_KB, S, diag || !__all(selq), [&](int kc) { return selq && (!diag || kc <= qd); }, l); }
                } else {
                    const int jb = w0 + t - n_sel; f32x16 st[2]; qk64(KT, qf, st, r, h); const bool diag = jb == m, far = jb == m - 8;
                    sm_pv64(st, KT + AT_KB, S, diag || far, [&](int kc) { return diag ? kc <= qd : (far ? kc > qd : true); }, l);
                }
            }
        }
        __syncthreads();
    }
#undef AT_LOAD1
    att_fold(tot, S, gt[32 + head]);
#undef AT_LOAD
#undef AT_PUT
    att_store(tot, w.G16 + (size_t)qrow * D + head * 64, h);
}

constexpr int ATS_SM = 8 * AT_BUF;
__device__ __forceinline__ void wave_load_f32(LAS unsigned char* WK, LAS unsigned char* WV, const float* base  , unsigned stride, int l) {
    const unsigned c16 = l & 15, kq = l >> 4; const unsigned lo = kq * stride + 4u * c16;
    LAS unsigned char* wk = WK + kq * AT_KST + (c16 >> 1) * 16 + (c16 & 1) * 8; LAS unsigned char* wv = WV + kq * 128 + c16 * 8;
#pragma unroll
    for (int half = 0; half < 2; ++half) { f32x4 v[16];
#pragma unroll
        for (int i = 0; i < 16; ++i) v[i] = *(const f32x4*)(base + (lo + (unsigned)(4 * i) * stride + (unsigned)half * 256u));
#pragma unroll
        for (int i = 0; i < 16; ++i) { const u32x2 pk = pkh4(v[i]);
            if (half == 0) *(LAS u32x2*)(wk + 4 * i * AT_KST) = pk; else *(LAS u32x2*)(wv + 4 * i * 128) = pk; } }
}
__device__ __forceinline__ void wave_load_new(LAS unsigned char* WK, LAS unsigned char* WV, const h16* kv16rows  , int kslot, int l) {
    const u32x4 z = {0u, 0u, 0u, 0u};
#pragma unroll
    for (int it = 0; it < 8; ++it) { *(LAS u32x4*)(WK + (it * 64 + l) * 16) = z; *(LAS u32x4*)(WV + (it * 64 + l) * 16) = z; }
    const int row = l >> 3, c = l & 7; const h16* p = kv16rows + (size_t)row * 1024 + kslot * 256 + c * 8;
    const u32x4 kk = *(const u32x4*)p, vv = *(const u32x4*)(p + 256);
    *(LAS u32x4*)(WK + kaddr(row, c)) = kk; *(LAS u32x4*)(WV + row * 128 + c * 16) = vv;
}
__device__ __forceinline__ void attn_sample_unit(const Frame& F, const Args& args, int b, int kvh) {
    const MW& w = args.w; int l = F.lane(); asm volatile("" : "+v"(l));
    const int r = l & 31, h = l >> 5, W = F.wave, t = r >> 2, gh = r & 3, head = kvh * 4 + gh;
    const int qrow = RP + b * LS + t, qpos = PAST + t;
    LAS unsigned char* L = F.lds; LAS unsigned char* WK = L + W * AT_BUF; LAS unsigned char* WV = WK + AT_KB;
    LAS float* WMX = (LAS float*)(L + ATS_SM); LAS float* WSM = WMX + 256; LAS float* WMX2 = WMX + 512; LAS float* WSM2 = WMX + 768; LAS float* WMX3 = WMX + 1024; LAS float* WSM3 = WMX + 1280;
    LAS unsigned* SELW = (LAS unsigned*)(L + ATS_SM + 6144); LAS float* TOTw = (LAS float*)(WK + 4096);
    const float* cache = (const float*)args.in[2]; const float* cwin = (const float*)args.in[3]; const int* ptab = (const int*)args.in[7];
    const float* gt = w.GATE + (size_t)qrow * 48;
#pragma unroll
    for (int it = 0; it < 8; ++it) { const int id = it * 64 + l, row = id >> 3, c = id & 7, i = 64 * W + row; u32x4 kk = {0u, 0u, 0u, 0u}, vv = {0u, 0u, 0u, 0u};
        if (i < NC_S) { const size_t o = ((size_t)(b * NC_S + i) * 4 + kvh) * 64 + c * 8; kk = *(const u32x4*)(w.KC16s + o); vv = *(const u32x4*)(w.VC16s + o); }
        *(LAS u32x4*)(WK + kaddr(row, c)) = kk; *(LAS u32x4*)(WV + row * 128 + c * 16) = vv; }
    h8v qf[4];
#pragma unroll
    for (int ks = 0; ks < 4; ++ks) qf[ks] = *(const h8v*)(w.QP16 + (size_t)qrow * D + head * 64 + 16 * ks + 8 * h);
    f32x16 tot[2];
    {
        f32x16 st[2]; qk64(WK, qf, st, r, h);
        const int clim = NC_S - 64 * W - 4 * h, qc = qpos - 31 - 1024 * W - 64 * h;
        float mx = NEG;
#pragma unroll
        for (int kt = 0; kt < 2; ++kt)
#pragma unroll
            for (int reg = 0; reg < 16; ++reg) { const int kc = keyc(kt, reg); const float v = (kc < clim && 16 * kc <= qc) ? st[kt][reg] : NEG; st[kt][reg] = v; mx = fmaxf(mx, v); }
        mx = fmaxf(mx, xhalf(mx));
        if (h == 0) WMX[W * 32 + r] = mx;
        __syncthreads();
        float gm = NEG;
#pragma unroll
        for (int ww = 0; ww < 8; ++ww) gm = fmaxf(gm, WMX[ww * 32 + r]);
        float sum = 0.f;
#pragma unroll
        for (int kt = 0; kt < 2; ++kt)
#pragma unroll
            for (int reg = 0; reg < 16; ++reg) { const float p = (st[kt][reg] <= 0.5f * NEG) ? 0.f : ex2(st[kt][reg] - gm); st[kt][reg] = p; sum += p; }
        sum += xhalf(sum);
        if (h == 0) WSM[W * 32 + r] = sum;
        __syncthreads();
        float ts = 0.f;
#pragma unroll
        for (int ww = 0; ww < 8; ++ww) ts += WSM[ww * 32 + r];
        const float inv = ts > 0.f ? 1.f / ts : 0.f;
#pragma unroll
        for (int kt = 0; kt < 2; ++kt)
#pragma unroll
            for (int reg = 0; reg < 16; ++reg) st[kt][reg] *= inv;
        LAS float* SCw = (LAS float*)WK;
#pragma unroll
        for (int kt = 0; kt < 2; ++kt)
#pragma unroll
            for (int g4 = 0; g4 < 4; ++g4) { const int ml = 8 * kt + 2 * g4 + h;
                SCw[ml * 32 + r] = 2.f * (st[kt][4 * g4] + st[kt][4 * g4 + 1] + st[kt][4 * g4 + 2]) + st[kt][4 * g4 + 3]; SCw[512 + ml * 32 + r] = st[kt][4 * g4 + 3]; }
        f32x16 oc[2];
#pragma unroll
        for (int dt = 0; dt < 2; ++dt) oc[dt] = (f32x16){0.f, 0.f, 0.f, 0.f, 0.f, 0.f, 0.f, 0.f, 0.f, 0.f, 0.f, 0.f, 0.f, 0.f, 0.f, 0.f};
        pv64(st, WV, oc, l);
#pragma unroll
        for (int dt = 0; dt < 2; ++dt)
#pragma unroll
            for (int reg = 0; reg < 16; ++reg) tot[dt][reg] = gt[head] * oc[dt][reg];
    }
    __syncthreads();
    {
        float me[3];
#pragma unroll
        for (int e = 0; e < 3; ++e) { const int j = e < 2 ? l + 64 * e : 128; float a = 0.f;
            if (e < 2 || l == 0) {
#pragma unroll
                for (int g = 0; g < 4; ++g) { const int col = 4 * W + g;
                    if (j < 128) a += ((const LAS float*)(L + (j >> 4) * AT_BUF))[(j & 15) * 32 + col];
                    if (j > 0) a += ((const LAS float*)(L + ((j - 1) >> 4) * AT_BUF))[512 + ((j - 1) & 15) * 32 + col]; }
                const bool forced = (j == 0) || (j == 128) || (j == 127);
                me[e] = forced ? INFINITY : a; TOTw[j] = me[e];
            } else me[e] = -INFINITY; }
        asm volatile("s_waitcnt lgkmcnt(0)" ::: "memory");
        int rank[3] = {0, 0, 0};
#pragma unroll 1
        for (int j2 = 0; j2 < NS_S; ++j2) { const float o = TOTw[j2];
#pragma unroll
            for (int e = 0; e < 3; ++e) { const int j = e < 2 ? l + 64 * e : 128; rank[e] += (o > me[e] || (o == me[e] && j2 < j)) ? 1 : 0; } }
        const unsigned long long b0 = __ballot(rank[0] < NSEL), b1 = __ballot(rank[1] < NSEL), b2 = __ballot(l == 0 && rank[2] < NSEL);
        if (l == 0) { SELW[W * 8 + 0] = (unsigned)b0; SELW[W * 8 + 1] = (unsigned)(b0 >> 32); SELW[W * 8 + 2] = (unsigned)b1; SELW[W * 8 + 3] = (unsigned)(b1 >> 32); SELW[W * 8 + 4] = (unsigned)(b2 & 1ull); }
    }
    __syncthreads();
    const h16* qrp = w.QR16 + (size_t)qrow * D + head * 64 + 8 * h;
#define ATS_LOADQ() do { asm volatile("" ::: "memory"); _Pragma("unroll") for (int ks = 0; ks < 4; ++ks) qf[ks] = *(const h8v*)(qrp + 16 * ks); } while (0)
    const h16* newrows = w.KV16 + (size_t)(RP + b * LS) * 1024 + kvh * 64;
    AttSt S; att_reset(S);
    const int td = t - 4 * h, tw = t - 64 * W - 4 * h;
    for (int jb = W; jb < NS_S; jb += 8) {
        unsigned uw = 0u;
#pragma unroll
        for (int tt = 0; tt < 8; ++tt) uw |= SELW[tt * 8 + (jb >> 5)];
        if (!((uw >> (jb & 31)) & 1u)) continue;
        if (jb < 128) { const int page = __builtin_amdgcn_readfirstlane(ptab[b * NPAGES + (jb >> 1)]);
            const float* base = cache + (((size_t)page * PAGE + (jb & 1) * 64) * 4 + 2) * 256 + kvh * 64;
            wave_load_f32(WK, WV, base, 1024u, l); }
        else wave_load_new(WK, WV, newrows, 0, l);
        const unsigned sw = SELW[t * 8 + (jb >> 5)];
        const bool selq = (sw >> (jb & 31)) & 1u; const bool isnew = jb == 128;
        ATS_LOADQ(); f32x16 st[2]; qk64(WK, qf, st, r, h);
        sm_pv64(st, WV, S, true, [&](int kc) { return selq && (!isnew || kc <= td); }, l);
    }
    { const float lt = S.lrun + xhalf(S.lrun); if (h == 0) { WMX2[W * 32 + r] = S.mrun; WSM2[W * 32 + r] = lt; } }
    __syncthreads();
    { float gm = NEG;
#pragma unroll
      for (int ww = 0; ww < 8; ++ww) gm = fmaxf(gm, WMX2[ww * 32 + r]);
      float gl = 0.f;
#pragma unroll
      for (int ww = 0; ww < 8; ++ww) gl += WSM2[ww * 32 + r] * ex2(WMX2[ww * 32 + r] - gm);
      const float f = gl > 0.f ? gt[16 + head] * ex2(S.mrun - gm) / gl : 0.f;
#pragma unroll
      for (int dt = 0; dt < 2; ++dt)
#pragma unroll
          for (int reg = 0; reg < 16; ++reg) tot[dt][reg] += f * S.o[dt][reg]; }
    att_reset(S);
    { const float* base = cwin + ((size_t)(b * WIN + 64 * W) * 2) * 256 + kvh * 64;
      wave_load_f32(WK, WV, base, 512u, l);
      ATS_LOADQ(); f32x16 st[2]; qk64(WK, qf, st, r, h);
      sm_pv64(st, WV, S, W == 0, [&](int kc) { return kc > tw; }, l); }
    if (W == 0) { wave_load_new(WK, WV, newrows, 2, l); ATS_LOADQ(); f32x16 st[2]; qk64(WK, qf, st, r, h); sm_pv64(st, WV, S, true, [&](int kc) { return kc <= td; }, l); }
    { const float lt = S.lrun + xhalf(S.lrun); if (h == 0) { WMX3[W * 32 + r] = S.mrun; WSM3[W * 32 + r] = lt; } }
    __syncthreads();
    { float gm = NEG;
#pragma unroll
      for (int ww = 0; ww < 8; ++ww) gm = fmaxf(gm, WMX3[ww * 32 + r]);
      float gl = 0.f;
#pragma unroll
      for (int ww = 0; ww < 8; ++ww) gl += WSM3[ww * 32 + r] * ex2(WMX3[ww * 32 + r] - gm);
      const float f = gl > 0.f ? gt[32 + head] * ex2(S.mrun - gm) / gl : 0.f;
#pragma unroll
      for (int dt = 0; dt < 2; ++dt)
#pragma unroll
          for (int reg = 0; reg < 16; ++reg) tot[dt][reg] += f * S.o[dt][reg]; }
    { LAS float* PART = (LAS float*)WK + 4 * h * 32 + r;
#pragma unroll
      for (int dt = 0; dt < 2; ++dt)
#pragma unroll
          for (int reg = 0; reg < 16; ++reg) PART[(32 * dt + (reg & 3) + 8 * (reg >> 2)) * 32] = tot[dt][reg]; }
    __syncthreads();
    { int tid = F.tid(); asm volatile("" : "+v"(tid)); const int col = tid >> 4, d0 = (tid & 15) * 4; f32x4 a = {0.f, 0.f, 0.f, 0.f};
#pragma unroll
      for (int ww = 0; ww < 8; ++ww) { const LAS float* P = (const LAS float*)(L + ww * AT_BUF);
#pragma unroll
          for (int e = 0; e < 4; ++e) a[e] += P[(d0 + e) * 32 + col]; }
      *(u32x2*)(w.G16 + (size_t)(RP + b * LS + (col >> 2)) * D + (kvh * 4 + (col & 3)) * 64 + d0) = pkh4(a); }
    __syncthreads();
}

#undef ATS_LOADQ
constexpr int CW_ATTQ = 512;
__device__ __forceinline__ void attn_phase(const Frame& F, const Args& args, int pass) {
    volatile LAS int* slot = (volatile LAS int*)(F.lds + LDS_MISC + 64);
    constexpr int NU = BS * KVH + BP * KVH * 32;
    for (;;) {
        if (F.tid() == 0) slot[0] = (int)__hip_atomic_fetch_add(args.w.ctl + CW_ATTQ + 64 * pass, 1u, __ATOMIC_RELAXED, __HIP_MEMORY_SCOPE_AGENT);
        __syncthreads();
        const int u = slot[0];
        __syncthreads();
        if (u >= NU) break;
        if (u < BS * KVH) attn_sample_unit(F, args, u >> 2, u & 3);
        else { const int v = u - BS * KVH; attn_prompt_unit(F, args, (v & 31) >> 2, v & 3, 31 - (v >> 5)); }
    }
}
constexpr int NPHASE = 19;
constexpr int CW_BAR = 1024;
__global__ void __launch_bounds__(NT, 2) mega(Args args) {
    extern __shared__ __attribute__((aligned(16))) unsigned char lds_raw[];
    Frame F; F.lds = (LAS unsigned char*)lds_raw; F.wave = __builtin_amdgcn_readfirstlane(threadIdx.x >> 6); F.G = gridDim.x; F.bid = blockIdx.x;
    const MW& w = args.w;
    volatile LAS unsigned* MISC = (volatile LAS unsigned*)(F.lds + LDS_MISC);
    if (F.tid() < 64) MISC[F.tid()] = 0u;
    __syncthreads();
    const int lo = args.ph_lo, hi = args.ph_hi;
    XcdBarrier bar; bar.bar = w.ctl + CW_BAR; bar.x = 0; bar.st = nullptr;
    if (hi - lo > 1) bar = xcd_barrier_post(w.ctl + CW_BAR, MISC + 8, F.wave);
    constexpr int pass = 0;
#ifndef PHASE_MASK
#define PHASE_MASK 0xFFFFFFFFu
#endif
#define IN(k) (((PHASE_MASK >> (k)) & 1u) && lo <= (k) && (k) < hi)
#define SEAM(k) do { if (IN(k) && IN((k) + 1)) xcd_barrier(bar, F.wave); } while (0)
    float* X = w.out + O_Y;
    const float* MOD = w.MOD;

    if (IN(0)) { p0_prep(F, args); } SEAM(0);
    if (IN(1)) { RowPass P{}; P.xa = INP(0); P.xb = INP(1); P.w1 = INP(10); P.sh1 = 0; P.H1 = w.H16; row_pass<F_H1, 0>(F, MOD, P); } SEAM(1);
    if (IN(2)) { s5_phase(F, args); } SEAM(2);
    if (IN(3)) { { pg8::StaticOrder S; S.init(RP, D, F.G, F.bid); pg8::PlainLay L{w.G16, w.Wglu, D}; EpiGlu E{w.G16, INP(23), w.OUTH}; pg8::gemm_phase(F.lds, F.wave, D, S, L, E); }
                 { int wv2 = F.wave; asm volatile("" : "+s"(wv2)); pg8::SplitOrder S{F.G, F.bid, 16}; pg8::SplitLay L{w.G16 + (size_t)RP * D, w.Wglu, D}; EpiPart E{w.PART}; pg8::gemm_phase(F.lds, wv2, 256, S, L, E); } } SEAM(3);
    if (IN(4)) { RowPass P{}; P.xa = INP(0); P.xb = INP(1); P.O = w.OUTH; P.part = w.PART; P.nsplit = 4; P.glu_g = w.G16; P.glu_b = INP(23); P.wpost = INP(11); P.gate_off = 2048; P.XHout = w.XH; P.w1 = INP(10) + D; P.sh1 = 3072; P.H1 = w.H16; row_pass<F_O | F_PART | F_GLU | F_XHOUT | F_H1, 4>(F, MOD, P); } SEAM(4);
    if (IN(5)) { pg8::StaticOrder S; S.init(R, F2, F.G, F.bid); pg8::PlainLay L{w.H16, w.Wup0, D}; EpiUp E{w.UP16, w.out + O_CONV_P, w.out + O_CONV_S}; pg8::gemm_phase(F.lds, F.wave, D, S, L, E); } SEAM(5);
    if (IN(6)) { conv_phase(F, args, 0); } SEAM(6);
    if (IN(7)) { { pg8::StaticOrder S; S.init(RP, D, F.G, F.bid); pg8::PlainLay L{w.ACT16, w.Wdn0, FF}; EpiH16 E{w.OUTH, D}; pg8::gemm_phase(F.lds, F.wave, FF, S, L, E); }
                 { int wv2 = F.wave; asm volatile("" : "+s"(wv2)); pg8::SplitOrder S{F.G, F.bid, 44}; pg8::SplitLay L{w.ACT16 + (size_t)RP * FF, w.Wdn0, FF}; EpiPart E{w.PART}; pg8::gemm_phase(F.lds, wv2, 256, S, L, E); } } SEAM(7);
    if (IN(8)) { RowPass P{}; P.xh = w.XH; P.XHout = w.XH; P.O = w.OUTH; P.part = w.PART; P.nsplit = 11; P.wpost = INP(11) + D; P.gate_off = 3072 + 2048;
                 P.w1 = INP(28); P.sh1 = 12288; P.H1 = w.HKV16; P.w2 = INP(10) + 2 * D; P.sh2 = 6144; P.H2 = w.H16; row_pass<F_XH | F_XHOUT | F_O | F_PART | F_H1 | F_H2, 11>(F, MOD, P); } SEAM(8);
    if (IN(9)) { KvQgOrder S; S.init(F.G, F.bid); KvQgLay L{w.HKV16, w.Wkv, w.H16, w.Wqg}; EpiKvQg E{w.ROPE, w.KV16, w.CMPP, w.out, w.QP16, w.QR16, w.GATE}; pg8::gemm_phase(F.lds, F.wave, D, S, L, E); } SEAM(9);
    if (IN(10)) { { CmpOrderS S{F.G, F.bid}; CmpLayS L{w.CMP16, w.Wc1k, w.Wc1v}; EpiCmpS E{w.PBs16}; pg8::gemm_phase(F.lds, F.wave, 1024, S, L, E); }
                  { int wv2 = F.wave; asm volatile("" : "+s"(wv2)); CmpOrderP S{F.G, F.bid}; CmpLayP L{w.CMPP, w.Wc1k, w.Wc1v}; EpiCmpP E{w.PBp}; pg8::gemm_phase(F.lds, wv2, 256, S, L, E); } } SEAM(10);
    if (IN(11)) { cmp2_phase(F, args); } SEAM(11);
    if (IN(12)) { attn_phase(F, args, pass); } SEAM(12);
    if (IN(13)) { { pg8::StaticOrder S; S.init(RP, D, F.G, F.bid); pg8::PlainLay L{w.G16, w.Wo, D}; EpiH16 E{w.OUTH, D}; pg8::gemm_phase(F.lds, F.wave, D, S, L, E); }
                  { int wv2 = F.wave; asm volatile("" : "+s"(wv2)); pg8::SplitOrder S{F.G, F.bid, 16}; pg8::SplitLay L{w.G16 + (size_t)RP * D, w.Wo, D}; EpiPart E{w.PART}; pg8::gemm_phase(F.lds, wv2, 256, S, L, E); } } SEAM(13);
    if (IN(14)) { RowPass P{}; P.xh = w.XH; P.XHout = w.XH; P.O = w.OUTH; P.part = w.PART; P.nsplit = 4; P.wpost = INP(11) + 2 * D; P.gate_off = 6144 + 2048; P.w1 = INP(10) + 3 * D; P.sh1 = 9216; P.H1 = w.H16; row_pass<F_XH | F_XHOUT | F_O | F_PART | F_H1, 4>(F, MOD, P); } SEAM(14);
    if (IN(15)) { pg8::StaticOrder S; S.init(R, F2, F.G, F.bid); pg8::PlainLay L{w.H16, w.Wup1, D}; EpiUp E{w.UP16, w.out + O_CONV_P + (size_t)BP * 2 * F2, w.out + O_CONV_S + (size_t)BS * 2 * F2}; pg8::gemm_phase(F.lds, F.wave, D, S, L, E); } SEAM(15);
    if (IN(16)) { conv_phase(F, args, 1); } SEAM(16);
    if (IN(17)) { { pg8::StaticOrder S; S.init(RP, D, F.G, F.bid); pg8::PlainLay L{w.ACT16, w.Wdn1, FF}; EpiH16 E{w.OUTH, D}; pg8::gemm_phase(F.lds, F.wave, FF, S, L, E); }
                  { int wv2 = F.wave; asm volatile("" : "+s"(wv2)); pg8::SplitOrder S{F.G, F.bid, 44}; pg8::SplitLay L{w.ACT16 + (size_t)RP * FF, w.Wdn1, FF}; EpiPart E{w.PART}; pg8::gemm_phase(F.lds, wv2, 256, S, L, E); } } SEAM(17);
    if (IN(18)) { RowPass P{}; P.xh = w.XH; P.O = w.OUTH; P.part = w.PART; P.nsplit = 11; P.wpost = INP(11) + 3 * D; P.gate_off = 9216 + 2048; P.Xout = X; row_pass<F_XH | F_O | F_PART | F_XOUT, 11>(F, MOD, P); }


#undef IN
#undef SEAM
}
#undef INP
}
extern "C" void kernel_launch(void* const* d_in, const int* in_sizes, int n_in, void* d_out, int out_size, void* d_ws, size_t ws_size, hipStream_t stream) {
    using namespace cfg;
    if (n_in != 38 || out_size != (int)O_END) { fprintf(stderr, "kernel_launch: unexpected problem shape (n_in %d, out %d)\n", n_in, out_size); return; }
    char* ws = (char*)d_ws; size_t off = 0;
    auto carve = [&](size_t bytes) { char* p = ws + off; off += (bytes + 255) & ~(size_t)255; return p; };
    mk::Args a{};
    for (int i = 0; i < 38; ++i) a.in[i] = d_in[i];
    mk::MW& w = a.w;
    w.ctl = (unsigned*)carve(1 << 20);
    w.MOD = (float*)carve((size_t)NSEQ * MODW * 4); w.ROPE = (float2*)carve((size_t)NROPE * 32 * 8); w.CB = (float*)carve(256 * 4);
    w.Wglu = (mk::h16*)carve((size_t)D * D * 2); w.Wup0 = (mk::h16*)carve((size_t)F2 * D * 2); w.Wup1 = (mk::h16*)carve((size_t)F2 * D * 2);
    w.Wdn0 = (mk::h16*)carve((size_t)D * FF * 2); w.Wdn1 = (mk::h16*)carve((size_t)D * FF * 2); w.Wkv = (mk::h16*)carve((size_t)NKV * D * 2);
    w.Wqg = (mk::h16*)carve((size_t)1280 * D * 2); w.Wo = (mk::h16*)carve((size_t)D * D * 2); w.Wc1k = (mk::h16*)carve((size_t)256 * 1024 * 2); w.Wc1v = (mk::h16*)carve((size_t)256 * 1024 * 2);
    w.H16 = (mk::h16*)carve((size_t)(R + 64) * D * 2); w.G16 = (mk::h16*)carve((size_t)R * D * 2); w.UP16 = (mk::h16*)carve((size_t)R * F2 * 2); w.ACT16 = (mk::h16*)carve((size_t)R * FF * 2);
    w.HKV16 = (mk::h16*)carve((size_t)R * D * 2); w.KV16 = (mk::h16*)carve((size_t)R * 1024 * 2); w.CMPP = (mk::h16*)carve((size_t)RP * 512 * 2); w.QP16 = (mk::h16*)carve((size_t)R * D * 2); w.QR16 = (mk::h16*)carve((size_t)R * D * 2);
    w.CMP16 = (mk::h16*)carve((size_t)BS * PAST * 512 * 2);
    w.KC16p = (mk::h16*)carve((size_t)BP * 128 * 256 * 2); w.VC16p = (mk::h16*)carve((size_t)BP * 128 * 256 * 2); w.KC16s = (mk::h16*)carve((size_t)BS * 512 * 256 * 2); w.VC16s = (mk::h16*)carve((size_t)BS * 512 * 256 * 2);
    w.OUTF = (float*)carve(256); w.OUTH = (mk::h16*)carve((size_t)R * D * 2); w.GATE = (float*)carve((size_t)R * 48 * 4); w.PBp = (float*)carve((size_t)4 * 2 * 4096 * 256 * 4); w.PBs = (float*)carve(256); w.XH = (mk::h16*)carve((size_t)R * D * 2); w.PBs16 = (mk::h16*)carve((size_t)2 * 65536 * 256 * 2); w.PART = (float*)carve((size_t)11 * 256 * 1024 * 4);
    w.out = (float*)d_out;
    if (off > ws_size) { fprintf(stderr, "kernel_launch: workspace too small (%zu > %zu)\n", off, ws_size); return; }
    static int grid = 0;
    if (!grid) {
        int dev = 0, cus = 0, per_cu = 0;
        if (hipGetDevice(&dev) != hipSuccess || hipDeviceGetAttribute(&cus, hipDeviceAttributeMultiprocessorCount, dev) != hipSuccess) cus = 256;
        if (hipFuncSetAttribute((const void*)mk::mega, hipFuncAttributeMaxDynamicSharedMemorySize, mk::LDS_BYTES) != hipSuccess) fprintf(stderr, "kernel_launch: hipFuncSetAttribute failed\n");
        if (hipOccupancyMaxActiveBlocksPerMultiprocessor(&per_cu, (const void*)mk::mega, mk::NT, mk::LDS_BYTES) != hipSuccess || per_cu < 1)
            fprintf(stderr, "kernel_launch: occupancy query reports %d workgroups per CU\n", per_cu);
        (void)hipGetLastError();
        grid = cus > 0 ? cus : 256;
    }
    if (hipMemsetAsync(w.ctl, 0, 1 << 20, stream) != hipSuccess) { fprintf(stderr, "kernel_launch: memset failed\n"); return; }
    a.ph_lo = 0; a.ph_hi = mk::NPHASE;
    hipLaunchKernelGGL(mk::mega, dim3(grid), dim3(mk::NT), mk::LDS_BYTES, stream, a);
}
```
